# Optimizing an MI355X kernel written in HIP

```python
import math
import jax, jax.numpy as jnp
from jax import lax
import numpy as np

D_MODEL = 1024
BATCH = 8
SEQ = 4096
DEPTH = 2

N_MIXERS = 2
N_A = (DEPTH + 1) // 2
N_B = DEPTH // 2

LRU_WIDTH = D_MODEL
N_LRU_BLOCKS = 4
LRU_BLOCK = LRU_WIDTH // N_LRU_BLOCKS
CONV_WIDTH = 4
LRU_C = 8.0
A_MIN = 0.9
A_MAX = 0.999

HEAD_DIM = 64
N_HEADS = D_MODEL // HEAD_DIM
Q_BLOCK = 128

D_FF = int(math.ceil(8 * D_MODEL / 3 / 256)) * 256

RMS_EPS = 1e-6

kernel_name = "hybrid_rglru_stickbreaking_swiglu"


def rms_norm(x, g):
    xf = x.astype(jnp.float32)
    y = xf * lax.rsqrt(jnp.mean(xf * xf, axis=-1, keepdims=True) + RMS_EPS)
    return (y * g.astype(jnp.float32)).astype(x.dtype)


def causal_depthwise_conv(x, w, b):
    c = x.shape[-1]
    y = lax.conv_general_dilated(
        x, w.reshape(CONV_WIDTH, 1, c).astype(x.dtype),
        window_strides=(1,), padding=[(CONV_WIDTH - 1, 0)],
        dimension_numbers=("NWC", "WIO", "NWC"), feature_group_count=c)
    return y + b


def _linear_recurrence_combine(e1, e2):
    a1, b1 = e1
    a2, b2 = e2
    return a1 * a2, a2 * b1 + b2


def rg_lru_block(x, w_in, b_in, conv_w, conv_b, gate_w, gate_b, lam, w_out, b_out):
    bsz, seq, _ = x.shape
    u = jnp.einsum("bsd,de->bse", x, w_in) + b_in
    gate_branch, rec = u[..., :LRU_WIDTH], u[..., LRU_WIDTH:]
    rec = causal_depthwise_conv(rec, conv_w, conv_b)
    rec_blk = rec.reshape(bsz, seq, N_LRU_BLOCKS, LRU_BLOCK)
    gl = jnp.einsum("bsnc,gncd->gbsnd", rec_blk, gate_w).reshape(2, bsz, seq, LRU_WIDTH)
    gl = gl.astype(jnp.float32) + gate_b.astype(jnp.float32)[:, None, None, :]
    r_gate = jax.nn.sigmoid(gl[0])
    i_gate = jax.nn.sigmoid(gl[1])
    log_a = -LRU_C * r_gate * jax.nn.softplus(-lam.astype(jnp.float32))
    a = jnp.exp(log_a)
    mult = jnp.sqrt(-jnp.expm1(2.0 * log_a))
    b = mult * (i_gate * rec.astype(jnp.float32))
    _, h = lax.associative_scan(_linear_recurrence_combine, (a, b), axis=1)
    y = jax.nn.gelu(gate_branch, approximate=True) * h.astype(x.dtype)
    return jnp.einsum("bse,ed->bsd", y, w_out) + b_out


def stick_breaking_attention(x, w_qkv, w_o):
    bsz, seq, _ = x.shape
    qkv = jnp.einsum("bsd,de->bse", x, w_qkv).reshape(bsz, seq, 3, N_HEADS, HEAD_DIM)
    q = jnp.transpose(qkv[:, :, 0], (0, 2, 1, 3))
    k = jnp.transpose(qkv[:, :, 1], (0, 2, 1, 3))
    v = jnp.transpose(qkv[:, :, 2], (0, 2, 1, 3))
    scale = 1.0 / math.sqrt(HEAD_DIM)
    outs = []
    for blk in range(seq // Q_BLOCK):
        t0 = blk * Q_BLOCK
        t1 = t0 + Q_BLOCK
        qb = q[:, :, t0:t1]
        kb = k[:, :, :t1]
        vb = v[:, :, :t1]
        z = jnp.einsum("bhqd,bhkd->bhqk", qb, kb).astype(jnp.float32) * scale
        t_idx = t0 + jnp.arange(Q_BLOCK)[:, None]
        s_idx = jnp.arange(t1)[None, :]
        strict = s_idx < t_idx
        log_fail = jnp.where(strict, jax.nn.log_sigmoid(-z), 0.0)
        suffix = lax.cumsum(log_fail, axis=3, reverse=True) - log_fail
        weights = jnp.where(strict, jnp.exp(jax.nn.log_sigmoid(z) + suffix), 0.0)
        outs.append(jnp.einsum("bhqk,bhkd->bhqd", weights.astype(vb.dtype), vb))
    o = jnp.concatenate(outs, axis=2)
    o = jnp.transpose(o, (0, 2, 1, 3)).reshape(bsz, seq, N_HEADS * HEAD_DIM)
    return jnp.einsum("bse,ed->bsd", o, w_o)


def swiglu_ffn(x, w_in, w_out):
    gu = jnp.einsum("bsd,df->bsf", x, w_in)
    h = jax.nn.silu(gu[..., :D_FF]) * gu[..., D_FF:]
    return jnp.einsum("bsf,fd->bsd", h, w_out)


def setup_inputs(seed: int = 0) -> dict:
    key = jax.random.key(seed)
    ks = jax.random.split(key, 20)
    f32 = jnp.float32

    def nrm(k, shape, fan_in):
        return jax.random.normal(k, shape, f32) * (fan_in ** -0.5)

    x = jax.random.normal(ks[0], (BATCH, SEQ, D_MODEL), f32)
    mix_norm = 1.0 + 0.05 * jax.random.normal(ks[1], (DEPTH, D_MODEL), f32)
    ffn_norm = 1.0 + 0.05 * jax.random.normal(ks[2], (DEPTH, D_MODEL), f32)
    final_norm = 1.0 + 0.05 * jax.random.normal(ks[3], (D_MODEL,), f32)

    lru_w_in = nrm(ks[4], (N_A, D_MODEL, 2 * LRU_WIDTH), D_MODEL)
    lru_b_in = 0.02 * jax.random.normal(ks[5], (N_A, 2 * LRU_WIDTH), f32)
    lru_conv_w = nrm(ks[6], (N_A, CONV_WIDTH, LRU_WIDTH), CONV_WIDTH)
    lru_conv_b = 0.02 * jax.random.normal(ks[7], (N_A, LRU_WIDTH), f32)
    lru_gate_w = nrm(ks[8], (N_A, 2, N_LRU_BLOCKS, LRU_BLOCK, LRU_BLOCK), LRU_BLOCK)
    lru_gate_b = 0.02 * jax.random.normal(ks[9], (N_A, 2, LRU_WIDTH), f32)
    u = jax.random.uniform(ks[10], (N_A, LRU_WIDTH), f32, A_MIN, A_MAX)
    a0 = u ** (1.0 / LRU_C)
    lru_lambda = jnp.log(a0) - jnp.log1p(-a0)
    lru_w_out = nrm(ks[11], (N_A, LRU_WIDTH, D_MODEL), LRU_WIDTH)
    lru_b_out = 0.02 * jax.random.normal(ks[12], (N_A, D_MODEL), f32)

    attn_w_qkv = nrm(ks[13], (N_B, D_MODEL, 3 * N_HEADS * HEAD_DIM), D_MODEL)
    attn_w_o = nrm(ks[14], (N_B, N_HEADS * HEAD_DIM, D_MODEL), N_HEADS * HEAD_DIM)

    ffn_w_in = nrm(ks[15], (DEPTH, D_MODEL, 2 * D_FF), D_MODEL)
    ffn_w_out = nrm(ks[16], (DEPTH, D_FF, D_MODEL), D_FF)

    return {
        "x": x, "mix_norm": mix_norm, "ffn_norm": ffn_norm, "final_norm": final_norm,
        "lru_w_in": lru_w_in, "lru_b_in": lru_b_in, "lru_conv_w": lru_conv_w,
        "lru_conv_b": lru_conv_b, "lru_gate_w": lru_gate_w, "lru_gate_b": lru_gate_b,
        "lru_lambda": lru_lambda, "lru_w_out": lru_w_out, "lru_b_out": lru_b_out,
        "attn_w_qkv": attn_w_qkv, "attn_w_o": attn_w_o,
        "ffn_w_in": ffn_w_in, "ffn_w_out": ffn_w_out,
    }


def reference(x, mix_norm, ffn_norm, final_norm, lru_w_in, lru_b_in, lru_conv_w,
              lru_conv_b, lru_gate_w, lru_gate_b, lru_lambda, lru_w_out, lru_b_out,
              attn_w_qkv, attn_w_o, ffn_w_in, ffn_w_out):
    h = x
    for layer in range(DEPTH):
        mixer = layer % N_MIXERS
        j = layer // N_MIXERS
        hn = rms_norm(h, mix_norm[layer])
        if mixer == 0:
            mixed = rg_lru_block(hn, lru_w_in[j], lru_b_in[j], lru_conv_w[j], lru_conv_b[j],
                                 lru_gate_w[j], lru_gate_b[j], lru_lambda[j],
                                 lru_w_out[j], lru_b_out[j])
        else:
            mixed = stick_breaking_attention(hn, attn_w_qkv[j], attn_w_o[j])
        h = h + mixed
        h = h + swiglu_ffn(rms_norm(h, ffn_norm[layer]), ffn_w_in[layer], ffn_w_out[layer])
    return rms_norm(h, final_norm)
```

```cpp
#include <hip/hip_runtime.h>
#include <hip/hip_cooperative_groups.h>
#include <cstdio>
#include <cstdint>
namespace cg = cooperative_groups;
namespace pg8 {
#define PG8_LAS __attribute__((address_space(3)))
typedef unsigned short bf16_t;
typedef short bf16x8 __attribute__((ext_vector_type(8)));
typedef float f32x4 __attribute__((ext_vector_type(4)));
typedef unsigned u32x4 __attribute__((ext_vector_type(4)));
constexpr int BM = 256, BK = 64, HALF = 128, HTB = HALF * BK * 2  , STAGE_BYTES = 8 * HTB, NXCD = 8, WGM = 8;

__host__ __device__ __forceinline__ int lds_byte(int r, int c) { const int st = (r >> 4) * 2 + (c >> 5), rr = r & 15, cc = c & 31, ob = rr * 64 + cc * 2; return st * 1024 + (ob ^ (((ob >> 9) & 1) << 5)); }
__host__ __device__ __forceinline__ void stage_rc(int b, int& R, int& C) { const int st = b / 1024, sb = b % 1024, swz = sb ^ (((sb >> 9) & 1) << 5); R = (st >> 1) * 16 + swz / 64; C = (st & 1) * 32 + (swz % 64) / 2; }
__host__ __device__ __forceinline__ int perm32(int rho) { const int n = rho >> 4, i = rho & 15; return 8 * (i >> 2) + 4 * n + (i & 3); }

struct Unit { int pm, pn; };
struct Gemm { const bf16_t* A; const bf16_t* Bt; int M, N, K; };

struct StaticOrder {
    int nM, nN, nwg, G, c;
    __host__ __device__ void init(int M, int N, int G_, int c_) { nM = M / BM; nN = N / BM; nwg = nM * nN; G = G_; c = c_; }
    __host__ __device__ bool next(int i, Unit& u) const {
        const long L = (long)i * G + c; if (L >= nwg) return false;
        int wgid = (int)L; { const int q = nwg / NXCD, r = nwg % NXCD, xcd = wgid % NXCD, off = wgid / NXCD; wgid = (xcd < r ? xcd * (q + 1) : r * (q + 1) + (xcd - r) * q) + off; }
        const int nig = WGM * nN, gid = wgid / nig, fm = gid * WGM, gsz = (nM - fm) < WGM ? (nM - fm) : WGM;
        u.pm = fm + ((wgid % nig) % gsz); u.pn = (wgid % nig) / gsz; return true;
    }
    __device__ __forceinline__ void a_ready(const Unit&) const {}
    __device__ __forceinline__ void done(const Unit&) const {}
};

__device__ __forceinline__ unsigned cvt_pk_bf16(float lo, float hi) { unsigned r; asm volatile("v_cvt_pk_bf16_f32 %0, %1, %2" : "=v"(r) : "v"(lo), "v"(hi)); return r; }
typedef float f32x2 __attribute__((ext_vector_type(2)));
template <class Epi, class Sched, bool ALIGN_EPI = false, bool SP2 = false>
__device__ __forceinline__ void gemm_phase(PG8_LAS unsigned char* lds, const Gemm g, const Sched& S, const Epi& E) {
    const int tid = threadIdx.x, wid = __builtin_amdgcn_readfirstlane(tid >> 6), lane = tid & 63, wr = wid >> 2, wc = wid & 3, fr = lane & 15, fq = lane >> 4;
    int Kx_ = g.K; asm volatile("" : "+s"(Kx_)); const int K = Kx_, nt = K / BK;
    unsigned voffA[2], voffB[2];
#pragma unroll
    for (int i = 0; i < 2; ++i) { int R, C; stage_rc(tid * 16 + i * 8192, R, C); const int Rb = Epi::PERM ? ((R & ~31) + perm32(R & 31)) : R;
        voffA[i] = (unsigned)(R * K + C) * 2u; voffB[i] = (unsigned)(Rb * K + C) * 2u; }
    const size_t kstep = (size_t)(BK * 2);
    const size_t hstep = (size_t)HALF * K * 2;
    const size_t tstep = 2 * hstep;
    const unsigned ldsw = (unsigned)wid * 1024u;
    const int aoff = lds_byte(wr * 64 + fr, fq * 8), boff = lds_byte(wc * 32 + fr, fq * 8);
#define PG8_SA(b, h) (((b) * 2 + (h)) * HTB)
#define PG8_SB(b, h) ((4 + (b) * 2 + (h)) * HTB)
#define PG8_STAGE(bufoff, gbase, voff) do { _Pragma("unroll") for (int _i = 0; _i < 2; ++_i) \
        __builtin_amdgcn_global_load_lds((const unsigned*)((const char*)(gbase) + (voff)[_i]), (PG8_LAS unsigned*)(lds + (bufoff) + ldsw + _i * 8192), 16, 0, 0); } while (0)
#define PG8_LDA(dst, b, h) do { _Pragma("unroll") for (int m = 0; m < 4; ++m) _Pragma("unroll") for (int k = 0; k < 2; ++k) dst[m][k] = *(const PG8_LAS bf16x8*)(lds + PG8_SA(b, h) + aoff + m * 2048 + k * 1024); } while (0)
#define PG8_LDB(dst, b, h) do { _Pragma("unroll") for (int n = 0; n < 2; ++n) _Pragma("unroll") for (int k = 0; k < 2; ++k) dst[n][k] = *(const PG8_LAS bf16x8*)(lds + PG8_SB(b, h) + boff + n * 2048 + k * 1024); } while (0)
#define PG8_MMA(ai, bj, At, Bt) do { __builtin_amdgcn_s_setprio(1); _Pragma("unroll") for (int m = 0; m < 4; ++m) _Pragma("unroll") for (int n = 0; n < 2; ++n) _Pragma("unroll") for (int k = 0; k < 2; ++k) \
        acc[ai][bj][m][n] = __builtin_amdgcn_mfma_f32_16x16x32_bf16(Bt[n][k], At[m][k], acc[ai][bj][m][n], 0, 0, 0); __builtin_amdgcn_s_setprio(0); } while (0)
#define PG8_WAIT_V(n) asm volatile("s_waitcnt vmcnt(" #n ")" ::: "memory")
#define PG8_WAIT_L(n) asm volatile("s_waitcnt lgkmcnt(" #n ")" ::: "memory")
#define PG8_BAR __builtin_amdgcn_s_barrier()
#define PG8_SCHED __builtin_amdgcn_sched_barrier(0)
    Unit cur, nxt; int ui = 0;
    if (!S.next(0, cur)) return;
    f32x4 acc[2][2][4][2];
#pragma unroll
    for (int a = 0; a < 2; ++a)
#pragma unroll
        for (int b = 0; b < 2; ++b)
#pragma unroll
            for (int m = 0; m < 4; ++m)
#pragma unroll
                for (int n = 0; n < 2; ++n) acc[a][b][m][n] = (f32x4){0.f, 0.f, 0.f, 0.f};
    bf16x8 At[4][2], B0[2][2], B1[2][2];
    const char* cA = (const char*)g.A + (size_t)cur.pm * tstep; const char* cB = (const char*)g.Bt + (size_t)cur.pn * tstep;
    S.a_ready(cur);
    if constexpr (SP2) {
        PG8_STAGE(PG8_SB(0, 0), cB, voffB); PG8_STAGE(PG8_SB(0, 1), cB + hstep, voffB); PG8_STAGE(PG8_SA(0, 0), cA, voffA); PG8_STAGE(PG8_SA(0, 1), cA + hstep, voffA);
        if (wr == 1) PG8_BAR;
        PG8_WAIT_V(2); PG8_BAR;
        PG8_STAGE(PG8_SB(1, 0), cB + kstep, voffB); PG8_STAGE(PG8_SA(1, 0), cA + kstep, voffA); PG8_STAGE(PG8_SB(1, 1), cB + hstep + kstep, voffB);
        PG8_WAIT_V(6); PG8_BAR;
    } else {
        PG8_STAGE(PG8_SB(0, 0), cB, voffB); PG8_STAGE(PG8_SA(0, 0), cA, voffA); PG8_STAGE(PG8_SB(0, 1), cB + hstep, voffB); PG8_STAGE(PG8_SA(0, 1), cA + hstep, voffA);
        if (wr == 1) PG8_BAR;
        PG8_WAIT_V(4); PG8_BAR;
        PG8_STAGE(PG8_SB(1, 0), cB + kstep, voffB); PG8_STAGE(PG8_SA(1, 0), cA + kstep, voffA); PG8_STAGE(PG8_SB(1, 1), cB + hstep + kstep, voffB);
        PG8_WAIT_V(6); PG8_BAR;
    }
    for (;;) {
        const bool has_next = S.next(ui + 1, nxt);
        const char* nA = has_next ? (const char*)g.A + (size_t)nxt.pm * tstep : cA; const char* nB = has_next ? (const char*)g.Bt + (size_t)nxt.pn * tstep : cB;
        for (int t = 0; t < nt; t += 2) {
            const bool last = (t == nt - 2);
            const char* a1 = cA + (size_t)(t + 1) * kstep;
            const char* a2 = last ? nA : cA + (size_t)(t + 2) * kstep; const char* b2 = last ? nB : cB + (size_t)(t + 2) * kstep;
            const char* a3 = a2 + kstep; const char* b3 = b2 + kstep;
            if (last && has_next) S.a_ready(nxt);
            if constexpr (SP2) {
            PG8_LDB(B0, 0, 0); PG8_LDB(B1, 0, 1); PG8_SCHED; PG8_LDA(At, 0, 0); PG8_STAGE(PG8_SA(1, 1), a1 + hstep, voffA);
            PG8_WAIT_V(8); PG8_WAIT_L(0); PG8_BAR; PG8_MMA(0, 0, At, B0); PG8_MMA(0, 1, At, B1); PG8_BAR; PG8_SCHED;
            PG8_LDA(At, 0, 1); PG8_STAGE(PG8_SB(0, 0), b2, voffB); PG8_STAGE(PG8_SB(0, 1), b2 + hstep, voffB); PG8_STAGE(PG8_SA(0, 0), a2, voffA);
            PG8_WAIT_V(8); PG8_WAIT_L(0); PG8_BAR; PG8_MMA(1, 0, At, B0); PG8_MMA(1, 1, At, B1); PG8_BAR; PG8_SCHED;
            PG8_LDB(B0, 1, 0); PG8_LDB(B1, 1, 1); PG8_SCHED; PG8_LDA(At, 1, 0); PG8_STAGE(PG8_SA(0, 1), a2 + hstep, voffA);
            PG8_WAIT_V(8); PG8_WAIT_L(0); PG8_BAR; PG8_MMA(0, 0, At, B0); PG8_MMA(0, 1, At, B1); PG8_BAR; PG8_SCHED;
            PG8_LDA(At, 1, 1); PG8_STAGE(PG8_SB(1, 0), b3, voffB); PG8_STAGE(PG8_SB(1, 1), b3 + hstep, voffB); PG8_STAGE(PG8_SA(1, 0), a3, voffA);
            PG8_WAIT_V(8); PG8_WAIT_L(0); PG8_BAR; PG8_MMA(1, 0, At, B0); PG8_MMA(1, 1, At, B1); PG8_BAR; PG8_SCHED;
            } else {
            PG8_LDB(B0, 0, 0); PG8_SCHED; PG8_LDA(At, 0, 0); PG8_STAGE(PG8_SA(1, 1), a1 + hstep, voffA);
            PG8_WAIT_L(8); PG8_BAR; PG8_WAIT_L(0); PG8_MMA(0, 0, At, B0); PG8_BAR; PG8_SCHED;
            PG8_LDB(B1, 0, 1); PG8_STAGE(PG8_SB(0, 0), b2, voffB);
            PG8_BAR; PG8_WAIT_L(0); PG8_MMA(0, 1, At, B1); PG8_BAR;
            PG8_LDA(At, 0, 1); PG8_STAGE(PG8_SA(0, 0), a2, voffA);
            PG8_BAR; PG8_WAIT_L(0); PG8_MMA(1, 0, At, B0); PG8_BAR; PG8_SCHED;
            PG8_STAGE(PG8_SB(0, 1), b2 + hstep, voffB);
            PG8_WAIT_V(6); PG8_BAR; PG8_MMA(1, 1, At, B1); PG8_BAR;
            PG8_LDB(B0, 1, 0); PG8_SCHED; PG8_LDA(At, 1, 0); PG8_STAGE(PG8_SA(0, 1), a2 + hstep, voffA);
            PG8_WAIT_L(8); PG8_BAR; PG8_WAIT_L(0); PG8_MMA(0, 0, At, B0); PG8_BAR; PG8_SCHED;
            PG8_LDB(B1, 1, 1); PG8_STAGE(PG8_SB(1, 0), b3, voffB);
            PG8_BAR; PG8_WAIT_L(0); PG8_MMA(0, 1, At, B1); PG8_BAR;
            PG8_LDA(At, 1, 1); PG8_STAGE(PG8_SA(1, 0), a3, voffA);
            PG8_BAR; PG8_WAIT_L(0); PG8_MMA(1, 0, At, B0); PG8_BAR; PG8_SCHED;
            PG8_STAGE(PG8_SB(1, 1), b3 + hstep, voffB);
            PG8_WAIT_V(6); PG8_BAR; PG8_MMA(1, 1, At, B1); PG8_BAR;
            }
        }
        if constexpr (ALIGN_EPI) { if (wr == 0) PG8_BAR; }
        if constexpr (!Epi::AFTER_DRAIN) { E(acc, cur, wr, wc, fr, fq); S.done(cur); }
        if (!has_next) break;
#pragma unroll
        for (int a = 0; a < 2; ++a)
#pragma unroll
            for (int b = 0; b < 2; ++b)
#pragma unroll
                for (int m = 0; m < 4; ++m)
#pragma unroll
                    for (int n = 0; n < 2; ++n) acc[a][b][m][n] = (f32x4){0.f, 0.f, 0.f, 0.f};
        cur = nxt; cA = nA; cB = nB; ++ui;
        if constexpr (ALIGN_EPI) { if (wr == 1) PG8_BAR; }
    }
    PG8_WAIT_V(0);
    if constexpr (!ALIGN_EPI) { if (wr == 0) PG8_BAR; }
    PG8_BAR;
    if constexpr (Epi::AFTER_DRAIN) { E.fused(acc, cur, wr, wc, fr, fq, lds, wid, lane); S.done(cur); }
#undef PG8_SA
#undef PG8_SB
#undef PG8_STAGE
#undef PG8_LDA
#undef PG8_LDB
#undef PG8_MMA
#undef PG8_WAIT_V
#undef PG8_WAIT_L
#undef PG8_BAR
#undef PG8_SCHED
}
}
namespace pg8 {
typedef unsigned u32x2 __attribute__((ext_vector_type(2)));
__device__ __forceinline__ float bf_lo(unsigned w) { return __uint_as_float(w << 16); }
__device__ __forceinline__ float bf_hi(unsigned w) { return __uint_as_float(w & 0xffff0000u); }
__device__ __forceinline__ float fast_sigmoid(float x) { return __builtin_amdgcn_rcpf(1.0f + __builtin_amdgcn_exp2f(-1.4426950408889634f * x)); }
__device__ __forceinline__ float gelu_tanh(float x) {
    const float u2 = 1.5957691216057308f * (x + 0.044715f * x * x * x);
    return x * fast_sigmoid(u2);
}
__device__ __forceinline__ u32x4 pack8(const f32x4 a, const f32x4 b) { u32x4 w; w.x = cvt_pk_bf16(a[0], a[1]); w.y = cvt_pk_bf16(a[2], a[3]); w.z = cvt_pk_bf16(b[0], b[1]); w.w = cvt_pk_bf16(b[2], b[3]); return w; }
constexpr float RMS_EPS = 1e-6f;
__device__ __forceinline__ float row_rstd(const float* ss, int row) {
    const f32x4* p = (const f32x4*)(ss + (size_t)row * 16); const f32x4 a = p[0], b = p[1], c = p[2], d = p[3];
    const float s = ((a[0] + a[1]) + (a[2] + a[3])) + ((b[0] + b[1]) + (b[2] + b[3])) + ((c[0] + c[1]) + (c[2] + c[3])) + ((d[0] + d[1]) + (d[2] + d[3]));
    return __builtin_amdgcn_rsqf(s * (1.0f / 1024.0f) + RMS_EPS);
}

struct EpiLruIn {
    static constexpr bool PERM = true, AFTER_DRAIN = false;
    bf16_t* GB; bf16_t* RP; const float* bias;
    __device__ __forceinline__ void operator()(const f32x4 (&acc)[2][2][4][2], const Unit& u, int wr, int wc, int fr, int fq) const {
        const int row0 = u.pm * BM + wr * 64 + fr; const bool gate = u.pn < 4;
        const int colg = u.pn * BM + wc * 32 + 8 * fq; bf16_t* base = gate ? GB : RP; const int col0 = gate ? colg : colg - 1024;
        f32x4 bv[2][2];
#pragma unroll
        for (int bj = 0; bj < 2; ++bj)
#pragma unroll
            for (int n = 0; n < 2; ++n) bv[bj][n] = *(const f32x4*)(bias + colg + bj * HALF + 4 * n);
#pragma unroll
        for (int ai = 0; ai < 2; ++ai)
#pragma unroll
            for (int m = 0; m < 4; ++m) { bf16_t* rowp = base + (size_t)(row0 + ai * HALF + m * 16) * 1024 + col0;
#pragma unroll
                for (int bj = 0; bj < 2; ++bj) { f32x4 v0 = acc[ai][bj][m][0] + bv[bj][0], v1 = acc[ai][bj][m][1] + bv[bj][1];
                    if (gate) {
#pragma unroll
                        for (int e = 0; e < 4; ++e) { v0[e] = gelu_tanh(v0[e]); v1[e] = gelu_tanh(v1[e]); } }
                    *(u32x4*)(rowp + bj * HALF) = pack8(v0, v1); } }
    }
};

struct EpiGate {
    static constexpr bool PERM = true, AFTER_DRAIN = false;
    const bf16_t* REC; const float* gate_b; const float* cn_tab; float* Aout; float* Bout; int M;
    __device__ __forceinline__ void operator()(const f32x4 (&acc)[2][2][4][2], const Unit& u, int wr, int wc, int fr, int fq) const {
        const int blk = u.pn >> 1, half = u.pn & 1;
        const int rowA0 = u.pm * BM + wr * 64 + fr;
#pragma unroll
        for (int n = 0; n < 2; ++n) {
            const int cl = half * 128 + wc * 32 + 8 * fq + 4 * n;
            const int ch0 = blk * 256 + cl;
            const f32x4 cn = *(const f32x4*)(cn_tab + ch0), gr = *(const f32x4*)(gate_b + ch0), gi = *(const f32x4*)(gate_b + 1024 + ch0);
#pragma unroll
            for (int ai = 0; ai < 2; ++ai)
#pragma unroll
                for (int m = 0; m < 4; ++m) {
                    const int rowA = rowA0 + ai * HALF + m * 16; const int tok = rowA & (M - 1);
                    const u32x2 rw = *(const u32x2*)(REC + (size_t)rowA * 256 + cl);
                    const float rec[4] = {bf_lo(rw.x), bf_hi(rw.x), bf_lo(rw.y), bf_hi(rw.y)};
                    f32x4 av, bv;
#pragma unroll
                    for (int e = 0; e < 4; ++e) {
                        const float r = fast_sigmoid(acc[ai][0][m][n][e] + gr[e]), ig = fast_sigmoid(acc[ai][1][m][n][e] + gi[e]);
                        const float la = cn[e] * r; const float a = __builtin_amdgcn_exp2f(la * 1.4426950408889634f);
                        const float x = 2.0f * la;
                        const float pm2 = -x * (1.0f + x * 0.5f * (1.0f + x * (1.0f / 3.0f) * (1.0f + x * 0.25f * (1.0f + x * 0.2f * (1.0f + x * (1.0f / 6.0f))))));
                        const float m2 = (x > -0.35f) ? pm2 : (1.0f - a * a);
                        av[e] = a; bv[e] = __builtin_sqrtf(fmaxf(m2, 0.0f)) * ig * rec[e]; }
                    *(f32x4*)(Aout + (size_t)tok * 1024 + ch0) = av; *(f32x4*)(Bout + (size_t)tok * 1024 + ch0) = bv;
                    asm volatile("" ::: "memory");
                }
        }
    }
};

struct EpiResid {
    static constexpr bool PERM = true, AFTER_DRAIN = false;
    const float* resid; float* OutF; bf16_t* OutB; float* SS; const float* bias;
    __device__ __forceinline__ void operator()(const f32x4 (&acc)[2][2][4][2], const Unit& u, int wr, int wc, int fr, int fq) const {
        const int row0 = u.pm * BM + wr * 64 + fr; const int col0 = u.pn * BM + wc * 32 + 8 * fq;
        f32x4 bv[2][2];
#pragma unroll
        for (int bj = 0; bj < 2; ++bj)
#pragma unroll
            for (int n = 0; n < 2; ++n) bv[bj][n] = bias ? *(const f32x4*)(bias + col0 + bj * HALF + 4 * n) : (f32x4){0.f, 0.f, 0.f, 0.f};
#pragma unroll
        for (int ai = 0; ai < 2; ++ai)
#pragma unroll
            for (int m = 0; m < 4; ++m) { const int row = row0 + ai * HALF + m * 16; const size_t off = (size_t)row * 1024 + col0; float ssq = 0.f;
#pragma unroll
                for (int bj = 0; bj < 2; ++bj) {
                    const f32x4 r0 = *(const f32x4*)(resid + off + bj * HALF), r1 = *(const f32x4*)(resid + off + bj * HALF + 4);
                    const f32x4 v0 = acc[ai][bj][m][0] + bv[bj][0] + r0, v1 = acc[ai][bj][m][1] + bv[bj][1] + r1;
                    *(f32x4*)(OutF + off + bj * HALF) = v0; *(f32x4*)(OutF + off + bj * HALF + 4) = v1;
                    if (OutB) *(u32x4*)(OutB + off + bj * HALF) = pack8(v0, v1);
                    ssq += (v0[0] * v0[0] + v0[1] * v0[1]) + (v0[2] * v0[2] + v0[3] * v0[3]) + (v1[0] * v1[0] + v1[1] * v1[1]) + (v1[2] * v1[2] + v1[3] * v1[3]); }
                ssq += __shfl_xor(ssq, 16); ssq += __shfl_xor(ssq, 32);
                if (fq == 0) SS[(size_t)row * 16 + u.pn * 4 + wc] = ssq; }
    }
};

struct EpiSwiglu {
    static constexpr bool PERM = true, AFTER_DRAIN = false;
    const float* SS; bf16_t* HID; int ldh;
    __device__ __forceinline__ void operator()(const f32x4 (&acc)[2][2][4][2], const Unit& u, int wr, int wc, int fr, int fq) const {
        const int row0 = u.pm * BM + wr * 64 + fr; const int col0 = u.pn * HALF + wc * 32 + 8 * fq;
#pragma unroll
        for (int ai = 0; ai < 2; ++ai)
#pragma unroll
            for (int m = 0; m < 4; ++m) { const int row = row0 + ai * HALF + m * 16; const float rs = row_rstd(SS, row);
                f32x4 h[2];
#pragma unroll
                for (int n = 0; n < 2; ++n)
#pragma unroll
                    for (int e = 0; e < 4; ++e) { const float g = acc[ai][0][m][n][e] * rs, up = acc[ai][1][m][n][e] * rs; h[n][e] = g * fast_sigmoid(g) * up; }
                *(u32x4*)(HID + (size_t)row * ldh + col0) = pack8(h[0], h[1]); }
    }
};

struct EpiQKV {
    static constexpr bool PERM = true, AFTER_DRAIN = false;
    const float* SS; bf16_t* Q; size_t tstride; float qscale;
    __device__ __forceinline__ void operator()(const f32x4 (&acc)[2][2][4][2], const Unit& u, int wr, int wc, int fr, int fq) const {
        const int row0 = u.pm * BM + wr * 64 + fr; const int t = u.pn >> 2; const int col0 = (u.pn & 3) * BM + wc * 32 + 8 * fq;
        bf16_t* base = Q + (size_t)t * tstride; const float sc = t == 0 ? qscale : 1.0f;
#pragma unroll
        for (int ai = 0; ai < 2; ++ai)
#pragma unroll
            for (int m = 0; m < 4; ++m) { const int row = row0 + ai * HALF + m * 16; const float rs = row_rstd(SS, row) * sc;
#pragma unroll
                for (int bj = 0; bj < 2; ++bj) *(u32x4*)(base + (size_t)row * 1024 + col0 + bj * HALF) = pack8(acc[ai][bj][m][0] * rs, acc[ai][bj][m][1] * rs); }
    }
};

struct GateOrder {
    StaticOrder base;
    __device__ bool next(int i, Unit& u) const { if (!base.next(i, u)) return false; u.pn += 2 * (u.pm >> 7); return true; }
    __device__ __forceinline__ void a_ready(const Unit&) const {}
    __device__ __forceinline__ void done(const Unit&) const {}
};
}
namespace sba {
#define SB_LAS __attribute__((address_space(3)))
typedef unsigned short bf16_t;
typedef short bf16x8 __attribute__((ext_vector_type(8)));
typedef short s16x4 __attribute__((ext_vector_type(4)));
typedef float f32x16 __attribute__((ext_vector_type(16)));
typedef unsigned u32x4 __attribute__((ext_vector_type(4)));
typedef unsigned u32x2 __attribute__((ext_vector_type(2)));
constexpr int S = 4096, DM = 1024, PITCH = 144, TILE_B = 64 * PITCH, BUF_B = 2 * TILE_B;
constexpr int LDS_BYTES = 2 * BUF_B;
__device__ __forceinline__ unsigned cvtpk(float lo, float hi) { unsigned r; asm volatile("v_cvt_pk_bf16_f32 %0, %1, %2" : "=v"(r) : "v"(lo), "v"(hi)); return r; }
__device__ __forceinline__ s16x4 vtr(const SB_LAS unsigned char* p) { return __builtin_bit_cast(s16x4, __builtin_amdgcn_ds_read_tr16_b64_v4i16((SB_LAS s16x4*)p)); }

__device__ __forceinline__ void attn_unit(int b, int h, int qb, const bf16_t* Q, const bf16_t* K, const bf16_t* V, bf16_t* O, SB_LAS unsigned char* lds) {
    const int tid = threadIdx.x, lane = tid & 63, r32 = lane & 31, hi = lane >> 5; const int wid = __builtin_amdgcn_readfirstlane(tid >> 6);
    const size_t rowbase = (size_t)b * S; const int q0 = qb * 256; const int wq0 = q0 + wid * 32; const int qrow = wq0 + r32;
    bf16x8 qf[4];
    { const bf16_t* Qw = Q + (rowbase + qrow) * DM + h * 64;
#pragma unroll
      for (int d0 = 0; d0 < 4; ++d0) qf[d0] = *(const bf16x8*)(Qw + d0 * 16 + hi * 8); }
    const int ldrow = tid >> 3, ldch = tid & 7;
    const bf16_t* kg = K + (rowbase + ldrow) * DM + h * 64 + ldch * 8; const bf16_t* vg = V + (rowbase + ldrow) * DM + h * 64 + ldch * 8;
    const int ldoff = ldrow * PITCH + ldch * 16;
    const int NT = (q0 + 256) / 64;
    f32x16 o0 = {}, o1 = {}; float C = 1.0f;
    const int trq = (lane & 15) >> 2, trp = lane & 3, trblk = (lane >> 4) & 1;
    const int troff = (4 * hi + trq) * PITCH + (16 * trblk + 4 * trp) * 2;
    const int koff = r32 * PITCH + hi * 16;
    u32x4 kreg, vreg;
    { const size_t go = (size_t)(NT - 1) * 64 * DM; kreg = *(const u32x4*)(kg + go); vreg = *(const u32x4*)(vg + go); }
    *(SB_LAS u32x4*)(lds + ldoff) = kreg; *(SB_LAS u32x4*)(lds + TILE_B + ldoff) = vreg;
    __syncthreads();
    int cur = 0;
    for (int kt = NT - 1; kt >= 0; --kt) {
        if (kt > 0) { const size_t go = (size_t)(kt - 1) * 64 * DM; kreg = *(const u32x4*)(kg + go); vreg = *(const u32x4*)(vg + go); }
        const SB_LAS unsigned char* Kb = lds + cur * BUF_B; const SB_LAS unsigned char* Vb = Kb + TILE_B;
        if (64 * kt < wq0 + 31) {
#pragma unroll
            for (int hf = 1; hf >= 0; --hf) {
                const int kb = 64 * kt + 32 * hf;
                if (kb < wq0 + 31) {
                    f32x16 p = {};
#pragma unroll
                    for (int d0 = 0; d0 < 4; ++d0) { const bf16x8 kf = *(const SB_LAS bf16x8*)(Kb + (32 * hf) * PITCH + koff + d0 * 32); p = __builtin_amdgcn_mfma_f32_32x32x16_bf16(kf, qf[d0], p, 0, 0, 0); }
                    const bool need_mask = (kb + 31 >= wq0);
                    float f[16], w[16];
#pragma unroll
                    for (int r = 0; r < 16; ++r) {
                        float e = __builtin_amdgcn_exp2f(fminf(p[r], 120.0f));
                        if (need_mask) { const int key = kb + (r & 3) + 8 * (r >> 2) + 4 * hi; if (key >= qrow) e = 0.0f; }
                        const float fr_ = __builtin_amdgcn_rcpf(1.0f + e); f[r] = fr_; w[r] = e * fr_;
                    }
                    float G[4], oth[4], T[4];
#pragma unroll
                    for (int i = 0; i < 4; ++i) { G[i] = (f[4 * i] * f[4 * i + 1]) * (f[4 * i + 2] * f[4 * i + 3]); oth[i] = __shfl_xor(G[i], 32); T[i] = G[i] * oth[i]; }
                    float Sx[4]; Sx[3] = C; Sx[2] = C * T[3]; Sx[1] = Sx[2] * T[2]; Sx[0] = Sx[1] * T[1];
                    C = Sx[0] * T[0];
#pragma unroll
                    for (int i = 0; i < 4; ++i) { float E = Sx[i] * (hi ? 1.0f : oth[i]);
                        w[4 * i + 3] *= E; E *= f[4 * i + 3]; w[4 * i + 2] *= E; E *= f[4 * i + 2]; w[4 * i + 1] *= E; E *= f[4 * i + 1]; w[4 * i] *= E; }
                    u32x4 pw0, pw1;
                    pw0.x = cvtpk(w[0], w[1]); pw0.y = cvtpk(w[2], w[3]); pw0.z = cvtpk(w[4], w[5]); pw0.w = cvtpk(w[6], w[7]);
                    pw1.x = cvtpk(w[8], w[9]); pw1.y = cvtpk(w[10], w[11]); pw1.z = cvtpk(w[12], w[13]); pw1.w = cvtpk(w[14], w[15]);
                    const bf16x8 pa0 = __builtin_bit_cast(bf16x8, pw0), pa1 = __builtin_bit_cast(bf16x8, pw1);
                    const SB_LAS unsigned char* vb = Vb + (32 * hf) * PITCH + troff;
#pragma unroll
                    for (int ks = 0; ks < 2; ++ks) {
                        const s16x4 a00 = vtr(vb + (16 * ks) * PITCH), a01 = vtr(vb + (16 * ks + 8) * PITCH);
                        const s16x4 a10 = vtr(vb + (16 * ks) * PITCH + 64), a11 = vtr(vb + (16 * ks + 8) * PITCH + 64);
                        const bf16x8 v0 = (bf16x8){a00[0], a00[1], a00[2], a00[3], a01[0], a01[1], a01[2], a01[3]};
                        const bf16x8 v1 = (bf16x8){a10[0], a10[1], a10[2], a10[3], a11[0], a11[1], a11[2], a11[3]};
                        o0 = __builtin_amdgcn_mfma_f32_32x32x16_bf16(v0, ks ? pa1 : pa0, o0, 0, 0, 0);
                        o1 = __builtin_amdgcn_mfma_f32_32x32x16_bf16(v1, ks ? pa1 : pa0, o1, 0, 0, 0);
                    }
                }
            }
        }
        if (kt > 0) { SB_LAS unsigned char* nb = lds + (cur ^ 1) * BUF_B; *(SB_LAS u32x4*)(nb + ldoff) = kreg; *(SB_LAS u32x4*)(nb + TILE_B + ldoff) = vreg; }
        __syncthreads();
        cur ^= 1;
    }
    bf16_t* Ow = O + (rowbase + qrow) * DM + h * 64 + 4 * hi;
#pragma unroll
    for (int i = 0; i < 4; ++i) {
        u32x2 a, c; a.x = cvtpk(o0[4 * i], o0[4 * i + 1]); a.y = cvtpk(o0[4 * i + 2], o0[4 * i + 3]); c.x = cvtpk(o1[4 * i], o1[4 * i + 1]); c.y = cvtpk(o1[4 * i + 2], o1[4 * i + 3]);
        *(u32x2*)(Ow + 8 * i) = a; *(u32x2*)(Ow + 32 + 8 * i) = c; }
}
__device__ __forceinline__ void attn_phase(int vcu, int G, const bf16_t* Q, const bf16_t* K, const bf16_t* V, bf16_t* O, SB_LAS unsigned char* lds) {
    for (int v = vcu; v < 256; v += G) {
        const int bh = v >> 1, par = v & 1;
        for (int j = 0; j < 4; ++j) { const int s = 2 * j + par;
            attn_unit(bh >> 4, bh & 15, 15 - s, Q, K, V, O, lds);
            attn_unit(bh >> 4, bh & 15, s, Q, K, V, O, lds); }
    }
}
}
constexpr int NWAVES = 8, NTHREADS = 512;
constexpr int BATCH = 8, SEQ = 4096, D = 1024, M = BATCH * SEQ, FF = 2816, NFF2 = 2 * FF, NLRU2 = 2048, NQKV = 3072;
constexpr size_t MiB = 1u << 20;
constexpr size_t WS_WIN = 1 * MiB, WS_GW = 5 * MiB, WS_WOUT = 6 * MiB, WS_WQKV = 8 * MiB, WS_WO = 14 * MiB, WS_W1 = 16 * MiB  , WS_W2 = 38 * MiB  ;
constexpr size_t WS_CN = 49 * MiB;
constexpr size_t WS_SS = 50 * MiB  , WS_AGG = 58 * MiB  ;
constexpr size_t WS_XN0 = 64 * MiB, WS_RP = 128 * MiB, WS_A = 64 * MiB  , WS_GB = 192 * MiB, WS_REC = 256 * MiB, WS_B = 320 * MiB  ;
constexpr size_t WS_Y = 256 * MiB, WS_H = 64 * MiB  , WS_HB = 192 * MiB, WS_HID = 256 * MiB  ;
constexpr size_t WS_Q = 256 * MiB, WS_K = 320 * MiB, WS_V = 384 * MiB, WS_O = 448 * MiB, WS_END = 512 * MiB;
constexpr int LDS_BYTES = 147456;

#define LAS __attribute__((address_space(3)))
typedef unsigned short bf16;
typedef unsigned v4u __attribute__((ext_vector_type(4)));
typedef unsigned v2u __attribute__((ext_vector_type(2)));
typedef float f32x4 __attribute__((ext_vector_type(4)));
__device__ __forceinline__ unsigned f2bf(float f) { unsigned u = __builtin_bit_cast(unsigned, f); return (u + 0x7fffu + ((u >> 16) & 1u)) >> 16; }
__device__ __forceinline__ unsigned pk2(float lo, float hi) { return f2bf(lo) | (f2bf(hi) << 16); }
__device__ __forceinline__ float bflo(unsigned w) { return __uint_as_float(w << 16); }
__device__ __forceinline__ float bfhi(unsigned w) { return __uint_as_float(w & 0xffff0000u); }
__device__ __forceinline__ float wave_sum(float v) {
#pragma unroll
    for (int o = 1; o < 64; o <<= 1) v += __shfl_xor(v, o);
    return v;
}

struct Params {
    const float *x, *mix_norm, *ffn_norm, *final_norm, *lru_w_in, *lru_b_in, *lru_conv_w, *lru_conv_b, *lru_gate_w, *lru_gate_b, *lru_lambda, *lru_w_out, *lru_b_out,
                *attn_w_qkv, *attn_w_o, *ffn_w_in, *ffn_w_out;
    float* out; unsigned char* ws;
};

__device__ __forceinline__ void transpose_item(const float* W, int K, int N, bf16* WT, const float* gain, int mode, int base, int split, LAS float* scr, int item, int lane) {
    const int nblk = N / 32, kb = item / nblk, nb = item % nblk, k0 = 64 * kb, n0 = 32 * nb;
#pragma unroll 8
    for (int i = 0; i < 32; ++i) { const int kk = 2 * i + (lane >> 5); float v = W[(size_t)(k0 + kk) * N + n0 + (lane & 31)]; if (gain) v *= gain[k0 + kk]; scr[kk * 33 + (lane & 31)] = v; }
    asm volatile("s_waitcnt lgkmcnt(0)" ::: "memory");
    const int c = lane & 7;
#pragma unroll
    for (int j = 0; j < 4; ++j) { const int nl = (lane >> 3) + 8 * j; const int n = n0 + nl; const LAS float* s = scr + (8 * c) * 33 + nl;
        int dr; if (mode == 0) dr = base + n; else { const int hi_ = n >= split; const int nn = hi_ ? n - split : n; dr = base + (hi_ ? 128 : 0) + (nn >> 7) * 256 + (nn & 127); }
        v4u o; o.x = pk2(s[0 * 33], s[1 * 33]); o.y = pk2(s[2 * 33], s[3 * 33]); o.z = pk2(s[4 * 33], s[5 * 33]); o.w = pk2(s[6 * 33], s[7 * 33]);
        *(v4u*)(WT + (size_t)dr * K + k0 + 8 * c) = o; }
    asm volatile("s_waitcnt lgkmcnt(0)" ::: "memory");
}

__device__ __forceinline__ void rms_row_to_bf16(const float* xrow, const float* g, bf16* orow, int lane) {
    const f32x4* xr = (const f32x4*)xrow + lane; const f32x4* gr = (const f32x4*)g + lane;
    f32x4 v[4]; float s = 0.f;
#pragma unroll
    for (int j = 0; j < 4; ++j) { v[j] = xr[64 * j]; s += (v[j].x * v[j].x + v[j].y * v[j].y) + (v[j].z * v[j].z + v[j].w * v[j].w); }
    const float rstd = 1.0f / sqrtf(wave_sum(s) * (1.f / D) + 1e-6f);
    unsigned long long* o8 = (unsigned long long*)orow + lane;
#pragma unroll
    for (int j = 0; j < 4; ++j) { const f32x4 gg = gr[64 * j]; o8[64 * j] = (unsigned long long)pk2(v[j].x * rstd * gg.x, v[j].y * rstd * gg.y) | ((unsigned long long)pk2(v[j].z * rstd * gg.z, v[j].w * rstd * gg.w) << 32); }
}
__device__ __forceinline__ void rms_row_f32(float* xrow, const float* g, int lane) {
    f32x4* xr = (f32x4*)xrow + lane; const f32x4* gr = (const f32x4*)g + lane;
    f32x4 v[4]; float s = 0.f;
#pragma unroll
    for (int j = 0; j < 4; ++j) { v[j] = xr[64 * j]; s += (v[j].x * v[j].x + v[j].y * v[j].y) + (v[j].z * v[j].z + v[j].w * v[j].w); }
    const float rstd = 1.0f / sqrtf(wave_sum(s) * (1.f / D) + 1e-6f);
#pragma unroll
    for (int j = 0; j < 4; ++j) { const f32x4 gg = gr[64 * j]; xr[64 * j] = (f32x4){v[j].x * rstd * gg.x, v[j].y * rstd * gg.y, v[j].z * rstd * gg.z, v[j].w * rstd * gg.w}; }
}

__global__ void __launch_bounds__(NTHREADS, 2) hybrid_fwd(Params p) {
    extern __shared__ __attribute__((aligned(16))) unsigned char lds_raw[];
    LAS unsigned char* lds = (LAS unsigned char*)lds_raw;
    cg::grid_group grid = cg::this_grid();
    const int tid = threadIdx.x, lane = tid & 63, wave = __builtin_amdgcn_readfirstlane(tid >> 6);
    const int G = gridDim.x, bx = blockIdx.x; const int vcu = (G % 8 == 0) ? (bx % 8) * (G / 8) + bx / 8 : bx;
    const int gw = vcu * NWAVES + wave, NGW = G * NWAVES; const int gt = vcu * NTHREADS + tid, NGT = G * NTHREADS;
    unsigned char* ws = p.ws;
    bf16 *WinT = (bf16*)(ws + WS_WIN), *GwT = (bf16*)(ws + WS_GW), *WoutT = (bf16*)(ws + WS_WOUT), *WqkvT = (bf16*)(ws + WS_WQKV), *WoT = (bf16*)(ws + WS_WO), *W1T = (bf16*)(ws + WS_W1), *W2T = (bf16*)(ws + WS_W2);
    float* SS = (float*)(ws + WS_SS); float* AGGA = (float*)(ws + WS_AGG); float* AGGB = AGGA + (size_t)BATCH * 64 * D;
    bf16 *XN0 = (bf16*)(ws + WS_XN0), *RP = (bf16*)(ws + WS_RP), *GB = (bf16*)(ws + WS_GB), *REC = (bf16*)(ws + WS_REC), *Y = (bf16*)(ws + WS_Y), *HB = (bf16*)(ws + WS_HB), *HID = (bf16*)(ws + WS_HID);
    bf16 *Qb = (bf16*)(ws + WS_Q), *Kb = (bf16*)(ws + WS_K), *Vb = (bf16*)(ws + WS_V), *Ob = (bf16*)(ws + WS_O);
    float* CN = (float*)(ws + WS_CN);
    float *Aa = (float*)(ws + WS_A), *Ba = (float*)(ws + WS_B), *H = (float*)(ws + WS_H);
    constexpr size_t SS_STRIDE = (size_t)M * 16;

    {
        LAS float* scr = (LAS float*)(lds + wave * 16384);
        constexpr int I_WIN = (D / 64) * (NLRU2 / 32), I_G1 = (256 / 64) * (256 / 32), I_G = 8 * I_G1, I_SQ = (D / 64) * (D / 32), I_QKV = (D / 64) * (NQKV / 32), I_W1 = (D / 64) * (NFF2 / 32), I_W2 = (FF / 64) * (D / 32);
        constexpr int NITEMS = I_WIN + I_G + I_SQ + I_QKV + I_SQ + 2 * I_W1 + 2 * I_W2;
        for (int it = gw; it < NITEMS; it += NGW) {
            int r = it;
            if (r < I_WIN) { transpose_item(p.lru_w_in, D, NLRU2, WinT, nullptr, 0, 0, 0, scr, r, lane); continue; } r -= I_WIN;
            if (r < I_G) { const int mi = r / I_G1, g = mi >> 2, blk = mi & 3;
                transpose_item(p.lru_gate_w + (size_t)mi * 65536, 256, 256, GwT, nullptr, 1, blk * 512 + g * 128, 1 << 30, scr, r % I_G1, lane); continue; } r -= I_G;
            if (r < I_SQ) { transpose_item(p.lru_w_out, D, D, WoutT, nullptr, 0, 0, 0, scr, r, lane); continue; } r -= I_SQ;
            if (r < I_QKV) { transpose_item(p.attn_w_qkv, D, NQKV, WqkvT, p.mix_norm + D, 0, 0, 0, scr, r, lane); continue; } r -= I_QKV;
            if (r < I_SQ) { transpose_item(p.attn_w_o, D, D, WoT, nullptr, 0, 0, 0, scr, r, lane); continue; } r -= I_SQ;
            if (r < 2 * I_W1) { const int l = r / I_W1; transpose_item(p.ffn_w_in + (size_t)l * D * NFF2, D, NFF2, W1T + (size_t)l * NFF2 * D, p.ffn_norm + l * D, 1, 0, FF, scr, r % I_W1, lane); continue; } r -= 2 * I_W1;
            { const int l = r / I_W2; transpose_item(p.ffn_w_out + (size_t)l * FF * D, FF, D, W2T + (size_t)l * D * FF, nullptr, 0, 0, 0, scr, r % I_W2, lane); }
        }
        for (int m = gw; m < M; m += NGW) rms_row_to_bf16(p.x + (size_t)m * D, p.mix_norm, XN0 + (size_t)m * D, lane);
        if (gt < D) CN[gt] = -8.0f * log1pf(expf(-p.lru_lambda[gt]));
    }
    grid.sync();

    {
        pg8::Gemm g{XN0, WinT, M, NLRU2, D}; pg8::StaticOrder S; S.init(M, NLRU2, G, bx);
        pg8::EpiLruIn E{GB, RP, p.lru_b_in};
        pg8::gemm_phase<pg8::EpiLruIn, pg8::StaticOrder, true, true>(lds, g, S, E);
    }
    grid.sync();

    {
        for (int it = gt; it < (M / 8) * 128; it += NGT) {
            const int cc = it & 127, tg = it >> 7; const int row0 = tg * 8, t0 = row0 & (SEQ - 1), ch = cc * 8;
            float wk[4][8], bia[8];
#pragma unroll
            for (int k = 0; k < 4; ++k) { const f32x4 a = *(const f32x4*)(p.lru_conv_w + k * D + ch), b = *(const f32x4*)(p.lru_conv_w + k * D + ch + 4);
                wk[k][0] = a.x; wk[k][1] = a.y; wk[k][2] = a.z; wk[k][3] = a.w; wk[k][4] = b.x; wk[k][5] = b.y; wk[k][6] = b.z; wk[k][7] = b.w; }
            { const f32x4 a = *(const f32x4*)(p.lru_conv_b + ch), b = *(const f32x4*)(p.lru_conv_b + ch + 4); bia[0] = a.x; bia[1] = a.y; bia[2] = a.z; bia[3] = a.w; bia[4] = b.x; bia[5] = b.y; bia[6] = b.z; bia[7] = b.w; }
            v4u win[11];
#pragma unroll
            for (int i = 0; i < 11; ++i) { const int t = t0 - 3 + i; win[i] = (t >= 0) ? *(const v4u*)(RP + (size_t)(row0 - 3 + i) * D + ch) : (v4u){0u, 0u, 0u, 0u}; }
            bf16* dst = REC + ((size_t)(cc >> 5) * M + row0) * 256 + (cc & 31) * 8;
#pragma unroll
            for (int j = 0; j < 8; ++j) {
                float acc[8];
#pragma unroll
                for (int e = 0; e < 8; ++e) acc[e] = bia[e];
#pragma unroll
                for (int k = 0; k < 4; ++k) { const v4u x = win[j + k];
                    acc[0] += wk[k][0] * bflo(x.x); acc[1] += wk[k][1] * bfhi(x.x); acc[2] += wk[k][2] * bflo(x.y); acc[3] += wk[k][3] * bfhi(x.y);
                    acc[4] += wk[k][4] * bflo(x.z); acc[5] += wk[k][5] * bfhi(x.z); acc[6] += wk[k][6] * bflo(x.w); acc[7] += wk[k][7] * bfhi(x.w); }
                v4u o; o.x = pk2(acc[0], acc[1]); o.y = pk2(acc[2], acc[3]); o.z = pk2(acc[4], acc[5]); o.w = pk2(acc[6], acc[7]);
                *(v4u*)(dst + (size_t)j * 256) = o; }
        }
    }
    grid.sync();

    {
        pg8::Gemm g{REC, GwT, 4 * M, 512, 256}; pg8::GateOrder S; S.base.init(4 * M, 512, G, bx);
        pg8::EpiGate E{REC, p.lru_gate_b, CN, Aa, Ba, M};
        pg8::gemm_phase<pg8::EpiGate, pg8::GateOrder, true, true>(lds, g, S, E);
    }
    grid.sync();

    {
        for (int it = vcu; it < BATCH * 32; it += G) {
            const int b = it >> 5, c = ((it & 31) << 1) + (tid >> 8), ch = (tid & 255) * 4;
            const size_t base = ((size_t)b * SEQ + (size_t)c * 64) * D + ch;
            f32x4 Ap = {1.f, 1.f, 1.f, 1.f}, Hh = {0.f, 0.f, 0.f, 0.f};
#pragma unroll 8
            for (int t = 0; t < 64; ++t) { const f32x4 a = *(const f32x4*)(Aa + base + (size_t)t * D), bb = *(const f32x4*)(Ba + base + (size_t)t * D); Hh = a * Hh + bb; Ap = Ap * a; }
            const size_t ao = ((size_t)b * 64 + c) * D + ch; *(f32x4*)(AGGA + ao) = Ap; *(f32x4*)(AGGB + ao) = Hh;
        }
    }
    grid.sync();
    {
        for (int it = vcu; it < BATCH * 32; it += G) {
            const int b = it >> 5, c = ((it & 31) << 1) + (tid >> 8), ch = (tid & 255) * 4;
            f32x4 Hh = {0.f, 0.f, 0.f, 0.f};
            for (int cc = 0; cc < c; ++cc) { const size_t ao = ((size_t)b * 64 + cc) * D + ch; Hh = *(const f32x4*)(AGGA + ao) * Hh + *(const f32x4*)(AGGB + ao); }
            const size_t base = ((size_t)b * SEQ + (size_t)c * 64) * D + ch;
#pragma unroll 8
            for (int t = 0; t < 64; ++t) { const size_t o = base + (size_t)t * D; const f32x4 a = *(const f32x4*)(Aa + o), bb = *(const f32x4*)(Ba + o); Hh = a * Hh + bb;
                const v2u g = *(const v2u*)(GB + o); v2u y; y.x = pk2(bflo(g.x) * Hh.x, bfhi(g.x) * Hh.y); y.y = pk2(bflo(g.y) * Hh.z, bfhi(g.y) * Hh.w); *(v2u*)(Y + o) = y; }
        }
    }
    grid.sync();

    {
        pg8::Gemm g{Y, WoutT, M, D, D}; pg8::StaticOrder S; S.init(M, D, G, bx);
        pg8::EpiResid E{p.x, H, HB, SS, p.lru_b_out};
        pg8::gemm_phase<pg8::EpiResid, pg8::StaticOrder, true, true>(lds, g, S, E);
    }
    grid.sync();
    {
        pg8::Gemm g{HB, W1T, M, NFF2, D}; pg8::StaticOrder S; S.init(M, NFF2, G, bx);
        pg8::EpiSwiglu E{SS, HID, FF};
        pg8::gemm_phase<pg8::EpiSwiglu, pg8::StaticOrder, true, true>(lds, g, S, E);
    }
    grid.sync();
    {
        pg8::Gemm g{HID, W2T, M, D, FF}; pg8::StaticOrder S; S.init(M, D, G, bx);
        pg8::EpiResid E{H, H, HB, SS + SS_STRIDE, nullptr};
        pg8::gemm_phase<pg8::EpiResid, pg8::StaticOrder, true, true>(lds, g, S, E);
    }
    grid.sync();
    {
        pg8::Gemm g{HB, WqkvT, M, NQKV, D}; pg8::StaticOrder S; S.init(M, NQKV, G, bx);
        static_assert(WS_V - WS_K == WS_K - WS_Q, "Q|K|V equally spaced");
        pg8::EpiQKV E{SS + SS_STRIDE, Qb, (size_t)(WS_K - WS_Q) / 2, 0.125f * 1.4426950408889634f};
        pg8::gemm_phase<pg8::EpiQKV, pg8::StaticOrder, true, true>(lds, g, S, E);
    }
    grid.sync();
    sba::attn_phase(vcu, G, Qb, Kb, Vb, Ob, lds);
    grid.sync();
    {
        pg8::Gemm g{Ob, WoT, M, D, D}; pg8::StaticOrder S; S.init(M, D, G, bx);
        pg8::EpiResid E{H, H, HB, SS + 2 * SS_STRIDE, nullptr};
        pg8::gemm_phase<pg8::EpiResid, pg8::StaticOrder, true, true>(lds, g, S, E);
    }
    grid.sync();
    {
        pg8::Gemm g{HB, W1T + (size_t)NFF2 * D, M, NFF2, D}; pg8::StaticOrder S; S.init(M, NFF2, G, bx);
        pg8::EpiSwiglu E{SS + 2 * SS_STRIDE, HID, FF};
        pg8::gemm_phase<pg8::EpiSwiglu, pg8::StaticOrder, true, true>(lds, g, S, E);
    }
    grid.sync();
    {
        pg8::Gemm g{HID, W2T + (size_t)D * FF, M, D, FF}; pg8::StaticOrder S; S.init(M, D, G, bx);
        pg8::EpiResid E{H, p.out, nullptr, SS + 3 * SS_STRIDE, nullptr};
        pg8::gemm_phase<pg8::EpiResid, pg8::StaticOrder, true, true>(lds, g, S, E);
    }
    grid.sync();
    for (int m = gw; m < M; m += NGW) rms_row_f32(p.out + (size_t)m * D, p.final_norm, lane);
}

extern "C" void kernel_launch(void* const* d_in, const int* in_sizes, int n_in, void* d_out, int out_size, void* d_ws, size_t ws_size, hipStream_t stream) {
    static int grid = 0;
    if (grid == 0) {
        if (n_in != 17 || in_sizes[0] != M * D || out_size != M * D || ws_size < WS_END) { fprintf(stderr, "kernel_launch: unexpected shapes (n_in %d, in0 %d, out %d, ws %zu)\n", n_in, n_in > 0 ? in_sizes[0] : -1, out_size, ws_size); grid = -1; return; }
        int dev = 0, cus = 0, per_cu = 0;
        if (hipGetDevice(&dev) != hipSuccess || hipDeviceGetAttribute(&cus, hipDeviceAttributeMultiprocessorCount, dev) != hipSuccess) { grid = -1; return; }
        if (hipFuncSetAttribute((const void*)hybrid_fwd, hipFuncAttributeMaxDynamicSharedMemorySize, LDS_BYTES) != hipSuccess) { fprintf(stderr, "kernel_launch: hipFuncSetAttribute failed\n"); grid = -1; return; }
        if (hipOccupancyMaxActiveBlocksPerMultiprocessor(&per_cu, (const void*)hybrid_fwd, NTHREADS, LDS_BYTES) != hipSuccess || per_cu < 1) { fprintf(stderr, "kernel_launch: occupancy query says %d\n", per_cu); per_cu = 1; }
        (void)hipGetLastError();
        grid = cus;
    }
    if (grid < 0) return;
    Params p{};
    p.x = (const float*)d_in[0]; p.mix_norm = (const float*)d_in[1]; p.ffn_norm = (const float*)d_in[2]; p.final_norm = (const float*)d_in[3];
    p.lru_w_in = (const float*)d_in[4]; p.lru_b_in = (const float*)d_in[5]; p.lru_conv_w = (const float*)d_in[6]; p.lru_conv_b = (const float*)d_in[7];
    p.lru_gate_w = (const float*)d_in[8]; p.lru_gate_b = (const float*)d_in[9]; p.lru_lambda = (const float*)d_in[10]; p.lru_w_out = (const float*)d_in[11]; p.lru_b_out = (const float*)d_in[12];
    p.attn_w_qkv = (const float*)d_in[13]; p.attn_w_o = (const float*)d_in[14]; p.ffn_w_in = (const float*)d_in[15]; p.ffn_w_out = (const float*)d_in[16];
    p.out = (float*)d_out; p.ws = (unsigned char*)d_ws;
    void* args[] = {&p};
    hipError_t e = hipLaunchCooperativeKernel((const void*)hybrid_fwd, dim3(grid), dim3(NTHREADS), args, LDS_BYTES, stream);
    if (e != hipSuccess) fprintf(stderr, "kernel_launch: cooperative launch failed: %s (grid %d)\n", hipGetErrorString(e), grid);
}
```

```cpp
#include <hip/hip_runtime.h>
#include <hip/hip_cooperative_groups.h>
#include <cstdio>
#include <cstdint>
namespace cg = cooperative_groups;
namespace pg8 {
#define PG8_LAS __attribute__((address_space(3)))
typedef unsigned short bf16_t;
typedef short bf16x8 __attribute__((ext_vector_type(8)));
typedef float f32x4 __attribute__((ext_vector_type(4)));
typedef unsigned u32x4 __attribute__((ext_vector_type(4)));
constexpr int BM = 256, BK = 64, HALF = 128, HTB = HALF * BK * 2  , STAGE_BYTES = 8 * HTB, NXCD = 8, WGM = 8;

__host__ __device__ __forceinline__ int lds_byte(int r, int c) { const int st = (r >> 4) * 2 + (c >> 5), rr = r & 15, cc = c & 31, ob = rr * 64 + cc * 2; return st * 1024 + (ob ^ (((ob >> 9) & 1) << 5)); }
__host__ __device__ __forceinline__ void stage_rc(int b, int& R, int& C) { const int st = b / 1024, sb = b % 1024, swz = sb ^ (((sb >> 9) & 1) << 5); R = (st >> 1) * 16 + swz / 64; C = (st & 1) * 32 + (swz % 64) / 2; }
__host__ __device__ __forceinline__ int perm32(int rho) { const int n = rho >> 4, i = rho & 15; return 8 * (i >> 2) + 4 * n + (i & 3); }

struct Unit { int pm, pn; };
struct Gemm { const bf16_t* A; const bf16_t* Bt; int M, N, K; };

struct StaticOrder {
    int nM, nN, nwg, G, c;
    __host__ __device__ void init(int M, int N, int G_, int c_) { nM = M / BM; nN = N / BM; nwg = nM * nN; G = G_; c = c_; }
    __host__ __device__ bool next(int i, Unit& u) const {
        const long L = (long)i * G + c; if (L >= nwg) return false;
        int wgid = (int)L; { const int q = nwg / NXCD, r = nwg % NXCD, xcd = wgid % NXCD, off = wgid / NXCD; wgid = (xcd < r ? xcd * (q + 1) : r * (q + 1) + (xcd - r) * q) + off; }
        const int nig = WGM * nN, gid = wgid / nig, fm = gid * WGM, gsz = (nM - fm) < WGM ? (nM - fm) : WGM;
        u.pm = fm + ((wgid % nig) % gsz); u.pn = (wgid % nig) / gsz; return true;
    }
    __device__ __forceinline__ void a_ready(const Unit&) const {}
    __device__ __forceinline__ void done(const Unit&) const {}
};

__device__ __forceinline__ unsigned cvt_pk_bf16(float lo, float hi) { unsigned r; asm volatile("v_cvt_pk_bf16_f32 %0, %1, %2" : "=v"(r) : "v"(lo), "v"(hi)); return r; }
typedef float f32x2 __attribute__((ext_vector_type(2)));
template <class Epi, class Sched, bool ALIGN_EPI = false, bool SP2 = false>
__device__ __forceinline__ void gemm_phase(PG8_LAS unsigned char* lds, const Gemm g, const Sched& S, const Epi& E) {
    const int tid = threadIdx.x, wid = __builtin_amdgcn_readfirstlane(tid >> 6), lane = tid & 63, wr = wid >> 2, wc = wid & 3, fr = lane & 15, fq = lane >> 4;
    int Kx_ = g.K; asm volatile("" : "+s"(Kx_)); const int K = Kx_, nt = K / BK;
    unsigned voffA[2], voffB[2];
#pragma unroll
    for (int i = 0; i < 2; ++i) { int R, C; stage_rc(tid * 16 + i * 8192, R, C); const int Rb = Epi::PERM ? ((R & ~31) + perm32(R & 31)) : R;
        voffA[i] = (unsigned)(R * K + C) * 2u; voffB[i] = (unsigned)(Rb * K + C) * 2u; }
    const size_t kstep = (size_t)(BK * 2);
    const size_t hstep = (size_t)HALF * K * 2;
    const size_t tstep = 2 * hstep;
    const unsigned ldsw = (unsigned)wid * 1024u;
    const int aoff = lds_byte(wr * 64 + fr, fq * 8), boff = lds_byte(wc * 32 + fr, fq * 8);
#define PG8_SA(b, h) (((b) * 2 + (h)) * HTB)
#define PG8_SB(b, h) ((4 + (b) * 2 + (h)) * HTB)
#define PG8_STAGE(bufoff, gbase, voff) do { _Pragma("unroll") for (int _i = 0; _i < 2; ++_i) \
        __builtin_amdgcn_global_load_lds((const unsigned*)((const char*)(gbase) + (voff)[_i]), (PG8_LAS unsigned*)(lds + (bufoff) + ldsw + _i * 8192), 16, 0, 0); } while (0)
#define PG8_LDA(dst, b, h) do { _Pragma("unroll") for (int m = 0; m < 4; ++m) _Pragma("unroll") for (int k = 0; k < 2; ++k) dst[m][k] = *(const PG8_LAS bf16x8*)(lds + PG8_SA(b, h) + aoff + m * 2048 + k * 1024); } while (0)
#define PG8_LDB(dst, b, h) do { _Pragma("unroll") for (int n = 0; n < 2; ++n) _Pragma("unroll") for (int k = 0; k < 2; ++k) dst[n][k] = *(const PG8_LAS bf16x8*)(lds + PG8_SB(b, h) + boff + n * 2048 + k * 1024); } while (0)
#define PG8_MMA(ai, bj, At, Bt) do { __builtin_amdgcn_s_setprio(1); _Pragma("unroll") for (int m = 0; m < 4; ++m) _Pragma("unroll") for (int n = 0; n < 2; ++n) _Pragma("unroll") for (int k = 0; k < 2; ++k) \
        acc[ai][bj][m][n] = __builtin_amdgcn_mfma_f32_16x16x32_bf16(Bt[n][k], At[m][k], acc[ai][bj][m][n], 0, 0, 0); __builtin_amdgcn_s_setprio(0); } while (0)
#define PG8_WAIT_V(n) asm volatile("s_waitcnt vmcnt(" #n ")" ::: "memory")
#define PG8_WAIT_L(n) asm volatile("s_waitcnt lgkmcnt(" #n ")" ::: "memory")
#define PG8_BAR __builtin_amdgcn_s_barrier()
#define PG8_SCHED __builtin_amdgcn_sched_barrier(0)
    Unit cur, nxt; int ui = 0;
    if (!S.next(0, cur)) return;
    f32x4 acc[2][2][4][2];
#pragma unroll
    for (int a = 0; a < 2; ++a)
#pragma unroll
        for (int b = 0; b < 2; ++b)
#pragma unroll
            for (int m = 0; m < 4; ++m)
#pragma unroll
                for (int n = 0; n < 2; ++n) acc[a][b][m][n] = (f32x4){0.f, 0.f, 0.f, 0.f};
    bf16x8 At[4][2], B0[2][2], B1[2][2];
    const char* cA = (const char*)g.A + (size_t)cur.pm * tstep; const char* cB = (const char*)g.Bt + (size_t)cur.pn * tstep;
    S.a_ready(cur);
    if constexpr (SP2) {
        PG8_STAGE(PG8_SB(0, 0), cB, voffB); PG8_STAGE(PG8_SB(0, 1), cB + hstep, voffB); PG8_STAGE(PG8_SA(0, 0), cA, voffA); PG8_STAGE(PG8_SA(0, 1), cA + hstep, voffA);
        if (wr == 1) PG8_BAR;
        PG8_WAIT_V(2); PG8_BAR;
        PG8_STAGE(PG8_SB(1, 0), cB + kstep, voffB); PG8_STAGE(PG8_SA(1, 0), cA + kstep, voffA); PG8_STAGE(PG8_SB(1, 1), cB + hstep + kstep, voffB);
        PG8_WAIT_V(6); PG8_BAR;
    } else {
        PG8_STAGE(PG8_SB(0, 0), cB, voffB); PG8_STAGE(PG8_SA(0, 0), cA, voffA); PG8_STAGE(PG8_SB(0, 1), cB + hstep, voffB); PG8_STAGE(PG8_SA(0, 1), cA + hstep, voffA);
        if (wr == 1) PG8_BAR;
        PG8_WAIT_V(4); PG8_BAR;
        PG8_STAGE(PG8_SB(1, 0), cB + kstep, voffB); PG8_STAGE(PG8_SA(1, 0), cA + kstep, voffA); PG8_STAGE(PG8_SB(1, 1), cB + hstep + kstep, voffB);
        PG8_WAIT_V(6); PG8_BAR;
    }
    for (;;) {
        const bool has_next = S.next(ui + 1, nxt);
        const char* nA = has_next ? (const char*)g.A + (size_t)nxt.pm * tstep : cA; const char* nB = has_next ? (const char*)g.Bt + (size_t)nxt.pn * tstep : cB;
        for (int t = 0; t < nt; t += 2) {
            const bool last = (t == nt - 2);
            const char* a1 = cA + (size_t)(t + 1) * kstep;
            const char* a2 = last ? nA : cA + (size_t)(t + 2) * kstep; const char* b2 = last ? nB : cB + (size_t)(t + 2) * kstep;
            const char* a3 = a2 + kstep; const char* b3 = b2 + kstep;
            if (last && has_next) S.a_ready(nxt);
            if constexpr (SP2) {
            PG8_LDB(B0, 0, 0); PG8_LDB(B1, 0, 1); PG8_SCHED; PG8_LDA(At, 0, 0); PG8_STAGE(PG8_SA(1, 1), a1 + hstep, voffA);
            PG8_WAIT_V(8); PG8_WAIT_L(0); PG8_BAR; PG8_MMA(0, 0, At, B0); PG8_MMA(0, 1, At, B1); PG8_BAR; PG8_SCHED;
            PG8_LDA(At, 0, 1); PG8_STAGE(PG8_SB(0, 0), b2, voffB); PG8_STAGE(PG8_SB(0, 1), b2 + hstep, voffB); PG8_STAGE(PG8_SA(0, 0), a2, voffA);
            PG8_WAIT_V(8); PG8_WAIT_L(0); PG8_BAR; PG8_MMA(1, 0, At, B0); PG8_MMA(1, 1, At, B1); PG8_BAR; PG8_SCHED;
            PG8_LDB(B0, 1, 0); PG8_LDB(B1, 1, 1); PG8_SCHED; PG8_LDA(At, 1, 0); PG8_STAGE(PG8_SA(0, 1), a2 + hstep, voffA);
            PG8_WAIT_V(8); PG8_WAIT_L(0); PG8_BAR; PG8_MMA(0, 0, At, B0); PG8_MMA(0, 1, At, B1); PG8_BAR; PG8_SCHED;
            PG8_LDA(At, 1, 1); PG8_STAGE(PG8_SB(1, 0), b3, voffB); PG8_STAGE(PG8_SB(1, 1), b3 + hstep, voffB); PG8_STAGE(PG8_SA(1, 0), a3, voffA);
            PG8_WAIT_V(8); PG8_WAIT_L(0); PG8_BAR; PG8_MMA(1, 0, At, B0); PG8_MMA(1, 1, At, B1); PG8_BAR; PG8_SCHED;
            } else {
            PG8_LDB(B0, 0, 0); PG8_SCHED; PG8_LDA(At, 0, 0); PG8_STAGE(PG8_SA(1, 1), a1 + hstep, voffA);
            PG8_WAIT_L(8); PG8_BAR; PG8_WAIT_L(0); PG8_MMA(0, 0, At, B0); PG8_BAR; PG8_SCHED;
            PG8_LDB(B1, 0, 1); PG8_STAGE(PG8_SB(0, 0), b2, voffB);
            PG8_BAR; PG8_WAIT_L(0); PG8_MMA(0, 1, At, B1); PG8_BAR;
            PG8_LDA(At, 0, 1); PG8_STAGE(PG8_SA(0, 0), a2, voffA);
            PG8_BAR; PG8_WAIT_L(0); PG8_MMA(1, 0, At, B0); PG8_BAR; PG8_SCHED;
            PG8_STAGE(PG8_SB(0, 1), b2 + hstep, voffB);
            PG8_WAIT_V(6); PG8_BAR; PG8_MMA(1, 1, At, B1); PG8_BAR;
            PG8_LDB(B0, 1, 0); PG8_SCHED; PG8_LDA(At, 1, 0); PG8_STAGE(PG8_SA(0, 1), a2 + hstep, voffA);
            PG8_WAIT_L(8); PG8_BAR; PG8_WAIT_L(0); PG8_MMA(0, 0, At, B0); PG8_BAR; PG8_SCHED;
            PG8_LDB(B1, 1, 1); PG8_STAGE(PG8_SB(1, 0), b3, voffB);
            PG8_BAR; PG8_WAIT_L(0); PG8_MMA(0, 1, At, B1); PG8_BAR;
            PG8_LDA(At, 1, 1); PG8_STAGE(PG8_SA(1, 0), a3, voffA);
            PG8_BAR; PG8_WAIT_L(0); PG8_MMA(1, 0, At, B0); PG8_BAR; PG8_SCHED;
            PG8_STAGE(PG8_SB(1, 1), b3 + hstep, voffB);
            PG8_WAIT_V(6); PG8_BAR; PG8_MMA(1, 1, At, B1); PG8_BAR;
            }
        }
        if constexpr (ALIGN_EPI) { if (wr == 0) PG8_BAR; }
        if constexpr (!Epi::AFTER_DRAIN) { E(acc, cur, wr, wc, fr, fq); S.done(cur); }
        if (!has_next) break;
#pragma unroll
        for (int a = 0; a < 2; ++a)
#pragma unroll
            for (int b = 0; b < 2; ++b)
#pragma unroll
                for (int m = 0; m < 4; ++m)
#pragma unroll
                    for (int n = 0; n < 2; ++n) acc[a][b][m][n] = (f32x4){0.f, 0.f, 0.f, 0.f};
        cur = nxt; cA = nA; cB = nB; ++ui;
        if constexpr (ALIGN_EPI) { if (wr == 1) PG8_BAR; }
    }
    PG8_WAIT_V(0);
    if constexpr (!ALIGN_EPI) { if (wr == 0) PG8_BAR; }
    PG8_BAR;
    if constexpr (Epi::AFTER_DRAIN) { E.fused(acc, cur, wr, wc, fr, fq, lds, wid, lane); S.done(cur); }
#undef PG8_SA
#undef PG8_SB
#undef PG8_STAGE
#undef PG8_LDA
#undef PG8_LDB
#undef PG8_MMA
#undef PG8_WAIT_V
#undef PG8_WAIT_L
#undef PG8_BAR
#undef PG8_SCHED
}
}
namespace pg8 {
typedef unsigned u32x2 __attribute__((ext_vector_type(2)));
__device__ __forceinline__ float bf_lo(unsigned w) { return __uint_as_float(w << 16); }
__device__ __forceinline__ float bf_hi(unsigned w) { return __uint_as_float(w & 0xffff0000u); }
__device__ __forceinline__ float fast_sigmoid(float x) { return __builtin_amdgcn_rcpf(1.0f + __builtin_amdgcn_exp2f(-1.4426950408889634f * x)); }
__device__ __forceinline__ float gelu_tanh(float x) {
    const float u2 = 1.5957691216057308f * (x + 0.044715f * x * x * x);
    return x * fast_sigmoid(u2);
}
__device__ __forceinline__ u32x4 pack8(const f32x4 a, const f32x4 b) { u32x4 w; w.x = cvt_pk_bf16(a[0], a[1]); w.y = cvt_pk_bf16(a[2], a[3]); w.z = cvt_pk_bf16(b[0], b[1]); w.w = cvt_pk_bf16(b[2], b[3]); return w; }
constexpr float RMS_EPS = 1e-6f;
__device__ __forceinline__ float row_rstd(const float* ss, int row) {
    const f32x4* p = (const f32x4*)(ss + (size_t)row * 16); const f32x4 a = p[0], b = p[1], c = p[2], d = p[3];
    const float s = ((a[0] + a[1]) + (a[2] + a[3])) + ((b[0] + b[1]) + (b[2] + b[3])) + ((c[0] + c[1]) + (c[2] + c[3])) + ((d[0] + d[1]) + (d[2] + d[3]));
    return __builtin_amdgcn_rsqf(s * (1.0f / 1024.0f) + RMS_EPS);
}

struct EpiLruIn {
    static constexpr bool PERM = true, AFTER_DRAIN = false;
    bf16_t* GB; bf16_t* RP; const float* bias;
    __device__ __forceinline__ void operator()(const f32x4 (&acc)[2][2][4][2], const Unit& u, int wr, int wc, int fr, int fq) const {
        const int row0 = u.pm * BM + wr * 64 + fr; const bool gate = u.pn < 4;
        const int colg = u.pn * BM + wc * 32 + 8 * fq; bf16_t* base = gate ? GB : RP; const int col0 = gate ? colg : colg - 1024;
        f32x4 bv[2][2];
#pragma unroll
        for (int bj = 0; bj < 2; ++bj)
#pragma unroll
            for (int n = 0; n < 2; ++n) bv[bj][n] = *(const f32x4*)(bias + colg + bj * HALF + 4 * n);
#pragma unroll
        for (int ai = 0; ai < 2; ++ai)
#pragma unroll
            for (int m = 0; m < 4; ++m) { bf16_t* rowp = base + (size_t)(row0 + ai * HALF + m * 16) * 1024 + col0;
#pragma unroll
                for (int bj = 0; bj < 2; ++bj) { f32x4 v0 = acc[ai][bj][m][0] + bv[bj][0], v1 = acc[ai][bj][m][1] + bv[bj][1];
                    if (gate) {
#pragma unroll
                        for (int e = 0; e < 4; ++e) { v0[e] = gelu_tanh(v0[e]); v1[e] = gelu_tanh(v1[e]); } }
                    *(u32x4*)(rowp + bj * HALF) = pack8(v0, v1); } }
    }
};

struct EpiGate {
    static constexpr bool PERM = true, AFTER_DRAIN = false;
    const bf16_t* REC; const float* gate_b; const float* cn_tab; float* Aout; float* Bout; int M;
    __device__ __forceinline__ void operator()(const f32x4 (&acc)[2][2][4][2], const Unit& u, int wr, int wc, int fr, int fq) const {
        const int blk = u.pn >> 1, half = u.pn & 1;
        const int rowA0 = u.pm * BM + wr * 64 + fr;
#pragma unroll
        for (int n = 0; n < 2; ++n) {
            const int cl = half * 128 + wc * 32 + 8 * fq + 4 * n;
            const int ch0 = blk * 256 + cl;
            const f32x4 cn = *(const f32x4*)(cn_tab + ch0), gr = *(const f32x4*)(gate_b + ch0), gi = *(const f32x4*)(gate_b + 1024 + ch0);
#pragma unroll
            for (int ai = 0; ai < 2; ++ai)
#pragma unroll
                for (int m = 0; m < 4; ++m) {
                    const int rowA = rowA0 + ai * HALF + m * 16; const int tok = rowA & (M - 1);
                    const u32x2 rw = *(const u32x2*)(REC + (size_t)rowA * 256 + cl);
                    const float rec[4] = {bf_lo(rw.x), bf_hi(rw.x), bf_lo(rw.y), bf_hi(rw.y)};
                    f32x4 av, bv;
#pragma unroll
                    for (int e = 0; e < 4; ++e) {
                        const float r = fast_sigmoid(acc[ai][0][m][n][e] + gr[e]), ig = fast_sigmoid(acc[ai][1][m][n][e] + gi[e]);
                        const float la = cn[e] * r; const float a = __builtin_amdgcn_exp2f(la * 1.4426950408889634f);
                        const float x = 2.0f * la;
                        const float pm2 = -x * (1.0f + x * 0.5f * (1.0f + x * (1.0f / 3.0f) * (1.0f + x * 0.25f * (1.0f + x * 0.2f * (1.0f + x * (1.0f / 6.0f))))));
                        const float m2 = (x > -0.35f) ? pm2 : (1.0f - a * a);
                        av[e] = a; bv[e] = __builtin_sqrtf(fmaxf(m2, 0.0f)) * ig * rec[e]; }
                    *(f32x4*)(Aout + (size_t)tok * 1024 + ch0) = av; *(f32x4*)(Bout + (size_t)tok * 1024 + ch0) = bv;
                    asm volatile("" ::: "memory");
                }
        }
    }
};

struct EpiResid {
    static constexpr bool PERM = true, AFTER_DRAIN = false;
    const float* resid; float* OutF; bf16_t* OutB; float* SS; const float* bias;
    __device__ __forceinline__ void operator()(const f32x4 (&acc)[2][2][4][2], const Unit& u, int wr, int wc, int fr, int fq) const {
        const int row0 = u.pm * BM + wr * 64 + fr; const int col0 = u.pn * BM + wc * 32 + 8 * fq;
        f32x4 bv[2][2];
#pragma unroll
        for (int bj = 0; bj < 2; ++bj)
#pragma unroll
            for (int n = 0; n < 2; ++n) bv[bj][n] = bias ? *(const f32x4*)(bias + col0 + bj * HALF + 4 * n) : (f32x4){0.f, 0.f, 0.f, 0.f};
#pragma unroll
        for (int ai = 0; ai < 2; ++ai)
#pragma unroll
            for (int m = 0; m < 4; ++m) { const int row = row0 + ai * HALF + m * 16; const size_t off = (size_t)row * 1024 + col0; float ssq = 0.f;
#pragma unroll
                for (int bj = 0; bj < 2; ++bj) {
                    const f32x4 r0 = *(const f32x4*)(resid + off + bj * HALF), r1 = *(const f32x4*)(resid + off + bj * HALF + 4);
                    const f32x4 v0 = acc[ai][bj][m][0] + bv[bj][0] + r0, v1 = acc[ai][bj][m][1] + bv[bj][1] + r1;
                    *(f32x4*)(OutF + off + bj * HALF) = v0; *(f32x4*)(OutF + off + bj * HALF + 4) = v1;
                    if (OutB) *(u32x4*)(OutB + off + bj * HALF) = pack8(v0, v1);
                    ssq += (v0[0] * v0[0] + v0[1] * v0[1]) + (v0[2] * v0[2] + v0[3] * v0[3]) + (v1[0] * v1[0] + v1[1] * v1[1]) + (v1[2] * v1[2] + v1[3] * v1[3]); }
                ssq += __shfl_xor(ssq, 16); ssq += __shfl_xor(ssq, 32);
                if (fq == 0) SS[(size_t)row * 16 + u.pn * 4 + wc] = ssq; }
    }
};

struct EpiSwiglu {
    static constexpr bool PERM = true, AFTER_DRAIN = false;
    const float* SS; bf16_t* HID; int ldh;
    __device__ __forceinline__ void operator()(const f32x4 (&acc)[2][2][4][2], const Unit& u, int wr, int wc, int fr, int fq) const {
        const int row0 = u.pm * BM + wr * 64 + fr; const int col0 = u.pn * HALF + wc * 32 + 8 * fq;
#pragma unroll
        for (int ai = 0; ai < 2; ++ai)
#pragma unroll
            for (int m = 0; m < 4; ++m) { const int row = row0 + ai * HALF + m * 16; const float rs = row_rstd(SS, row);
                f32x4 h[2];
#pragma unroll
                for (int n = 0; n < 2; ++n)
#pragma unroll
                    for (int e = 0; e < 4; ++e) { const float g = acc[ai][0][m][n][e] * rs, up = acc[ai][1][m][n][e] * rs; h[n][e] = g * fast_sigmoid(g) * up; }
                *(u32x4*)(HID + (size_t)row * ldh + col0) = pack8(h[0], h[1]); }
    }
};

struct EpiQKV {
    static constexpr bool PERM = true, AFTER_DRAIN = false;
    const float* SS; bf16_t* Q; size_t tstride; float qscale;
    __device__ __forceinline__ void operator()(const f32x4 (&acc)[2][2][4][2], const Unit& u, int wr, int wc, int fr, int fq) const {
        const int row0 = u.pm * BM + wr * 64 + fr; const int t = u.pn >> 2; const int col0 = (u.pn & 3) * BM + wc * 32 + 8 * fq;
        bf16_t* base = Q + (size_t)t * tstride; const float sc = t == 0 ? qscale : 1.0f;
#pragma unroll
        for (int ai = 0; ai < 2; ++ai)
#pragma unroll
            for (int m = 0; m < 4; ++m) { const int row = row0 + ai * HALF + m * 16; const float rs = row_rstd(SS, row) * sc;
#pragma unroll
                for (int bj = 0; bj < 2; ++bj) *(u32x4*)(base + (size_t)row * 1024 + col0 + bj * HALF) = pack8(acc[ai][bj][m][0] * rs, acc[ai][bj][m][1] * rs); }
    }
};

struct GateOrder {
    StaticOrder base;
    __device__ bool next(int i, Unit& u) const { if (!base.next(i, u)) return false; u.pn += 2 * (u.pm >> 7); return true; }
    __device__ __forceinline__ void a_ready(const Unit&) const {}
    __device__ __forceinline__ void done(const Unit&) const {}
};
}
namespace sba {
#define SB_LAS __attribute__((address_space(3)))
typedef unsigned short bf16_t;
typedef short bf16x8 __attribute__((ext_vector_type(8)));
typedef short s16x4 __attribute__((ext_vector_type(4)));
typedef float f32x16 __attribute__((ext_vector_type(16)));
typedef unsigned u32x4 __attribute__((ext_vector_type(4)));
typedef unsigned u32x2 __attribute__((ext_vector_type(2)));
constexpr int S = 4096, DM = 1024, PITCH = 144, TILE_B = 64 * PITCH, BUF_B = 2 * TILE_B;
constexpr int LDS_BYTES = 2 * BUF_B;
__device__ __forceinline__ unsigned cvtpk(float lo, float hi) { unsigned r; asm volatile("v_cvt_pk_bf16_f32 %0, %1, %2" : "=v"(r) : "v"(lo), "v"(hi)); return r; }
__device__ __forceinline__ s16x4 vtr(const SB_LAS unsigned char* p) { return __builtin_bit_cast(s16x4, __builtin_amdgcn_ds_read_tr16_b64_v4i16((SB_LAS s16x4*)p)); }

__device__ __forceinline__ void attn_unit(int b, int h, int qb, const bf16_t* Q, const bf16_t* K, const bf16_t* V, bf16_t* O, SB_LAS unsigned char* lds) {
    const int tid = threadIdx.x, lane = tid & 63, r32 = lane & 31, hi = lane >> 5; const int wid = __builtin_amdgcn_readfirstlane(tid >> 6);
    const size_t rowbase = (size_t)b * S; const int q0 = qb * 256; const int wq0 = q0 + wid * 32; const int qrow = wq0 + r32;
    SB_LAS int* flg = (SB_LAS int*)(lds + LDS_BYTES);
    __syncthreads();
    if (lane == 0) flg[wid] = -1;
    bool wdone = false;
    bf16x8 qf[4];
    { const bf16_t* Qw = Q + (rowbase + qrow) * DM + h * 64;
#pragma unroll
      for (int d0 = 0; d0 < 4; ++d0) qf[d0] = *(const bf16x8*)(Qw + d0 * 16 + hi * 8); }
    const int ldrow = tid >> 3, ldch = tid & 7;
    const bf16_t* kg = K + (rowbase + ldrow) * DM + h * 64 + ldch * 8; const bf16_t* vg = V + (rowbase + ldrow) * DM + h * 64 + ldch * 8;
    const int ldoff = ldrow * PITCH + ldch * 16;
    const int NT = (q0 + 256) / 64;
    f32x16 o0 = {}, o1 = {}; float C = 1.0f;
    const int trq = (lane & 15) >> 2, trp = lane & 3, trblk = (lane >> 4) & 1;
    const int troff = (4 * hi + trq) * PITCH + (16 * trblk + 4 * trp) * 2;
    const int koff = r32 * PITCH + hi * 16;
    u32x4 kreg, vreg;
    { const size_t go = (size_t)(NT - 1) * 64 * DM; kreg = *(const u32x4*)(kg + go); vreg = *(const u32x4*)(vg + go); }
    *(SB_LAS u32x4*)(lds + ldoff) = kreg; *(SB_LAS u32x4*)(lds + TILE_B + ldoff) = vreg;
    __syncthreads();
    int cur = 0;
    for (int kt = NT - 1; kt >= 0; --kt) {
        if (kt > 0) { const size_t go = (size_t)(kt - 1) * 64 * DM; kreg = *(const u32x4*)(kg + go); vreg = *(const u32x4*)(vg + go); }
        const SB_LAS unsigned char* Kb = lds + cur * BUF_B; const SB_LAS unsigned char* Vb = Kb + TILE_B;
        if (!wdone && 64 * kt < wq0 + 31) {
#pragma unroll
            for (int hf = 1; hf >= 0; --hf) {
                const int kb = 64 * kt + 32 * hf;
                if (kb < wq0 + 31) {
                    f32x16 p = {};
#pragma unroll
                    for (int d0 = 0; d0 < 4; ++d0) { const bf16x8 kf = *(const SB_LAS bf16x8*)(Kb + (32 * hf) * PITCH + koff + d0 * 32); p = __builtin_amdgcn_mfma_f32_32x32x16_bf16(kf, qf[d0], p, 0, 0, 0); }
                    const bool need_mask = (kb + 31 >= wq0);
                    float f[16], w[16];
#pragma unroll
                    for (int r = 0; r < 16; ++r) {
                        float e = __builtin_amdgcn_exp2f(fminf(p[r], 120.0f));
                        if (need_mask) { const int key = kb + (r & 3) + 8 * (r >> 2) + 4 * hi; if (key >= qrow) e = 0.0f; }
                        const float fr_ = __builtin_amdgcn_rcpf(1.0f + e); f[r] = fr_; w[r] = e * fr_;
                    }
                    float T[4], Hm[4];
#pragma unroll
                    for (int i = 0; i < 4; ++i) { const float Gi = (f[4 * i] * f[4 * i + 1]) * (f[4 * i + 2] * f[4 * i + 3]);
                        const auto rr = __builtin_amdgcn_permlane32_swap(__float_as_uint(Gi), __float_as_uint(Gi), false, false);
                        const float Lo = __uint_as_float(rr[0]), Hi_ = __uint_as_float(rr[1]); T[i] = Lo * Hi_; Hm[i] = hi ? 1.0f : Hi_; }
                    float Sx[4]; Sx[3] = C; Sx[2] = C * T[3]; Sx[1] = Sx[2] * T[2]; Sx[0] = Sx[1] * T[1];
                    C = Sx[0] * T[0];
#pragma unroll
                    for (int i = 0; i < 4; ++i) { float E = Sx[i] * Hm[i];
                        w[4 * i + 3] *= E; E *= f[4 * i + 3]; w[4 * i + 2] *= E; E *= f[4 * i + 2]; w[4 * i + 1] *= E; E *= f[4 * i + 1]; w[4 * i] *= E; }
                    u32x4 pw0, pw1;
                    pw0.x = cvtpk(w[0], w[1]); pw0.y = cvtpk(w[2], w[3]); pw0.z = cvtpk(w[4], w[5]); pw0.w = cvtpk(w[6], w[7]);
                    pw1.x = cvtpk(w[8], w[9]); pw1.y = cvtpk(w[10], w[11]); pw1.z = cvtpk(w[12], w[13]); pw1.w = cvtpk(w[14], w[15]);
                    const bf16x8 pa0 = __builtin_bit_cast(bf16x8, pw0), pa1 = __builtin_bit_cast(bf16x8, pw1);
                    const SB_LAS unsigned char* vb = Vb + (32 * hf) * PITCH + troff;
#pragma unroll
                    for (int ks = 0; ks < 2; ++ks) {
                        const s16x4 a00 = vtr(vb + (16 * ks) * PITCH), a01 = vtr(vb + (16 * ks + 8) * PITCH);
                        const s16x4 a10 = vtr(vb + (16 * ks) * PITCH + 64), a11 = vtr(vb + (16 * ks + 8) * PITCH + 64);
                        const bf16x8 v0 = (bf16x8){a00[0], a00[1], a00[2], a00[3], a01[0], a01[1], a01[2], a01[3]};
                        const bf16x8 v1 = (bf16x8){a10[0], a10[1], a10[2], a10[3], a11[0], a11[1], a11[2], a11[3]};
                        o0 = __builtin_amdgcn_mfma_f32_32x32x16_bf16(v0, ks ? pa1 : pa0, o0, 0, 0, 0);
                        o1 = __builtin_amdgcn_mfma_f32_32x32x16_bf16(v1, ks ? pa1 : pa0, o1, 0, 0, 0);
                    }
                }
            }
            if (__builtin_amdgcn_ballot_w64(C != 0.0f) == 0ull) { wdone = true; if (lane == 0) flg[wid] = kt; }
        }
        if (kt > 0) { SB_LAS unsigned char* nb = lds + (cur ^ 1) * BUF_B; *(SB_LAS u32x4*)(nb + ldoff) = kreg; *(SB_LAS u32x4*)(nb + TILE_B + ldoff) = vreg; }
        __syncthreads();
        cur ^= 1;
        if (kt > 0) { typedef int i32x4 __attribute__((ext_vector_type(4))); const i32x4 fa = *(const SB_LAS i32x4*)flg, fb = *(const SB_LAS i32x4*)(flg + 4);
            const int mn = min(min(min(fa.x, fa.y), min(fa.z, fa.w)), min(min(fb.x, fb.y), min(fb.z, fb.w)));
            if (mn >= kt) break; }
    }
    bf16_t* Ow = O + (rowbase + qrow) * DM + h * 64 + 4 * hi;
#pragma unroll
    for (int i = 0; i < 4; ++i) {
        u32x2 a, c; a.x = cvtpk(o0[4 * i], o0[4 * i + 1]); a.y = cvtpk(o0[4 * i + 2], o0[4 * i + 3]); c.x = cvtpk(o1[4 * i], o1[4 * i + 1]); c.y = cvtpk(o1[4 * i + 2], o1[4 * i + 3]);
        *(u32x2*)(Ow + 8 * i) = a; *(u32x2*)(Ow + 32 + 8 * i) = c; }
}
__device__ __forceinline__ void attn_phase(int vcu, int G, const bf16_t* Q, const bf16_t* K, const bf16_t* V, bf16_t* O, SB_LAS unsigned char* lds) {
    for (int v = vcu; v < 256; v += G) {
        const int bh = v >> 1, par = v & 1;
        for (int j = 0; j < 4; ++j) { const int s = 2 * j + par;
            attn_unit(bh >> 4, bh & 15, 15 - s, Q, K, V, O, lds);
            attn_unit(bh >> 4, bh & 15, s, Q, K, V, O, lds); }
    }
}
}
constexpr int NWAVES = 8, NTHREADS = 512;
constexpr int BATCH = 8, SEQ = 4096, D = 1024, M = BATCH * SEQ, FF = 2816, NFF2 = 2 * FF, NLRU2 = 2048, NQKV = 3072;
constexpr size_t MiB = 1u << 20;
constexpr size_t WS_WIN = 1 * MiB, WS_GW = 5 * MiB, WS_WOUT = 6 * MiB, WS_WQKV = 8 * MiB, WS_WO = 14 * MiB, WS_W1 = 16 * MiB  , WS_W2 = 38 * MiB  ;
constexpr size_t WS_CN = 49 * MiB;
constexpr size_t WS_SS = 50 * MiB  , WS_AGG = 58 * MiB  ;
constexpr size_t WS_XN0 = 64 * MiB, WS_RP = 128 * MiB, WS_A = 64 * MiB  , WS_GB = 192 * MiB, WS_REC = 256 * MiB, WS_B = 320 * MiB  ;
constexpr size_t WS_Y = 256 * MiB, WS_H = 64 * MiB  , WS_HB = 192 * MiB, WS_HID = 256 * MiB  ;
constexpr size_t WS_Q = 256 * MiB, WS_K = 320 * MiB, WS_V = 384 * MiB, WS_O = 448 * MiB, WS_END = 512 * MiB;
constexpr int LDS_BYTES = 147456;

#define LAS __attribute__((address_space(3)))
typedef unsigned short bf16;
typedef unsigned v4u __attribute__((ext_vector_type(4)));
typedef unsigned v2u __attribute__((ext_vector_type(2)));
typedef float f32x4 __attribute__((ext_vector_type(4)));
__device__ __forceinline__ unsigned f2bf(float f) { unsigned u = __builtin_bit_cast(unsigned, f); return (u + 0x7fffu + ((u >> 16) & 1u)) >> 16; }
__device__ __forceinline__ unsigned pk2(float lo, float hi) { return f2bf(lo) | (f2bf(hi) << 16); }
__device__ __forceinline__ float bflo(unsigned w) { return __uint_as_float(w << 16); }
__device__ __forceinline__ float bfhi(unsigned w) { return __uint_as_float(w & 0xffff0000u); }
__device__ __forceinline__ float wave_sum(float v) {
#pragma unroll
    for (int o = 1; o < 64; o <<= 1) v += __shfl_xor(v, o);
    return v;
}

struct Params {
    const float *x, *mix_norm, *ffn_norm, *final_norm, *lru_w_in, *lru_b_in, *lru_conv_w, *lru_conv_b, *lru_gate_w, *lru_gate_b, *lru_lambda, *lru_w_out, *lru_b_out,
                *attn_w_qkv, *attn_w_o, *ffn_w_in, *ffn_w_out;
    float* out; unsigned char* ws;
};

__device__ __forceinline__ void transpose_item(const float* W, int K, int N, bf16* WT, const float* gain, int mode, int base, int split, LAS float* scr, int item, int lane) {
    const int nblk = N / 32, kb = item / nblk, nb = item % nblk, k0 = 64 * kb, n0 = 32 * nb;
#pragma unroll 8
    for (int i = 0; i < 32; ++i) { const int kk = 2 * i + (lane >> 5); float v = W[(size_t)(k0 + kk) * N + n0 + (lane & 31)]; if (gain) v *= gain[k0 + kk]; scr[kk * 33 + (lane & 31)] = v; }
    asm volatile("s_waitcnt lgkmcnt(0)" ::: "memory");
    const int c = lane & 7;
#pragma unroll
    for (int j = 0; j < 4; ++j) { const int nl = (lane >> 3) + 8 * j; const int n = n0 + nl; const LAS float* s = scr + (8 * c) * 33 + nl;
        int dr; if (mode == 0) dr = base + n; else { const int hi_ = n >= split; const int nn = hi_ ? n - split : n; dr = base + (hi_ ? 128 : 0) + (nn >> 7) * 256 + (nn & 127); }
        v4u o; o.x = pk2(s[0 * 33], s[1 * 33]); o.y = pk2(s[2 * 33], s[3 * 33]); o.z = pk2(s[4 * 33], s[5 * 33]); o.w = pk2(s[6 * 33], s[7 * 33]);
        *(v4u*)(WT + (size_t)dr * K + k0 + 8 * c) = o; }
    asm volatile("s_waitcnt lgkmcnt(0)" ::: "memory");
}

__device__ __forceinline__ void rms_row_to_bf16(const float* xrow, const float* g, bf16* orow, int lane) {
    const f32x4* xr = (const f32x4*)xrow + lane; const f32x4* gr = (const f32x4*)g + lane;
    f32x4 v[4]; float s = 0.f;
#pragma unroll
    for (int j = 0; j < 4; ++j) { v[j] = xr[64 * j]; s += (v[j].x * v[j].x + v[j].y * v[j].y) + (v[j].z * v[j].z + v[j].w * v[j].w); }
    const float rstd = 1.0f / sqrtf(wave_sum(s) * (1.f / D) + 1e-6f);
    unsigned long long* o8 = (unsigned long long*)orow + lane;
#pragma unroll
    for (int j = 0; j < 4; ++j) { const f32x4 gg = gr[64 * j]; o8[64 * j] = (unsigned long long)pk2(v[j].x * rstd * gg.x, v[j].y * rstd * gg.y) | ((unsigned long long)pk2(v[j].z * rstd * gg.z, v[j].w * rstd * gg.w) << 32); }
}
__device__ __forceinline__ void rms_row_f32(float* xrow, const float* g, int lane) {
    f32x4* xr = (f32x4*)xrow + lane; const f32x4* gr = (const f32x4*)g + lane;
    f32x4 v[4]; float s = 0.f;
#pragma unroll
    for (int j = 0; j < 4; ++j) { v[j] = xr[64 * j]; s += (v[j].x * v[j].x + v[j].y * v[j].y) + (v[j].z * v[j].z + v[j].w * v[j].w); }
    const float rstd = 1.0f / sqrtf(wave_sum(s) * (1.f / D) + 1e-6f);
#pragma unroll
    for (int j = 0; j < 4; ++j) { const f32x4 gg = gr[64 * j]; xr[64 * j] = (f32x4){v[j].x * rstd * gg.x, v[j].y * rstd * gg.y, v[j].z * rstd * gg.z, v[j].w * rstd * gg.w}; }
}

__global__ void __launch_bounds__(NTHREADS, 2) hybrid_fwd(Params p) {
    extern __shared__ __attribute__((aligned(16))) unsigned char lds_raw[];
    LAS unsigned char* lds = (LAS unsigned char*)lds_raw;
    cg::grid_group grid = cg::this_grid();
    const int tid = threadIdx.x, lane = tid & 63, wave = __builtin_amdgcn_readfirstlane(tid >> 6);
    const int G = gridDim.x, bx = blockIdx.x; const int vcu = (G % 8 == 0) ? (bx % 8) * (G / 8) + bx / 8 : bx;
    const int gw = vcu * NWAVES + wave, NGW = G * NWAVES; const int gt = vcu * NTHREADS + tid, NGT = G * NTHREADS;
    unsigned char* ws = p.ws;
    bf16 *WinT = (bf16*)(ws + WS_WIN), *GwT = (bf16*)(ws + WS_GW), *WoutT = (bf16*)(ws + WS_WOUT), *WqkvT = (bf16*)(ws + WS_WQKV), *WoT = (bf16*)(ws + WS_WO), *W1T = (bf16*)(ws + WS_W1), *W2T = (bf16*)(ws + WS_W2);
    float* SS = (float*)(ws + WS_SS); float* AGGA = (float*)(ws + WS_AGG); float* AGGB = AGGA + (size_t)BATCH * 64 * D;
    bf16 *XN0 = (bf16*)(ws + WS_XN0), *RP = (bf16*)(ws + WS_RP), *GB = (bf16*)(ws + WS_GB), *REC = (bf16*)(ws + WS_REC), *Y = (bf16*)(ws + WS_Y), *HB = (bf16*)(ws + WS_HB), *HID = (bf16*)(ws + WS_HID);
    bf16 *Qb = (bf16*)(ws + WS_Q), *Kb = (bf16*)(ws + WS_K), *Vb = (bf16*)(ws + WS_V), *Ob = (bf16*)(ws + WS_O);
    float* CN = (float*)(ws + WS_CN);
    float *Aa = (float*)(ws + WS_A), *Ba = (float*)(ws + WS_B), *H = (float*)(ws + WS_H);
    constexpr size_t SS_STRIDE = (size_t)M * 16;

    {
        LAS float* scr = (LAS float*)(lds + wave * 16384);
        constexpr int I_WIN = (D / 64) * (NLRU2 / 32), I_G1 = (256 / 64) * (256 / 32), I_G = 8 * I_G1, I_SQ = (D / 64) * (D / 32), I_QKV = (D / 64) * (NQKV / 32), I_W1 = (D / 64) * (NFF2 / 32), I_W2 = (FF / 64) * (D / 32);
        constexpr int NITEMS = I_WIN + I_G + I_SQ + I_QKV + I_SQ + 2 * I_W1 + 2 * I_W2;
        for (int it = gw; it < NITEMS; it += NGW) {
            int r = it;
            if (r < I_WIN) { transpose_item(p.lru_w_in, D, NLRU2, WinT, nullptr, 0, 0, 0, scr, r, lane); continue; } r -= I_WIN;
            if (r < I_G) { const int mi = r / I_G1, g = mi >> 2, blk = mi & 3;
                transpose_item(p.lru_gate_w + (size_t)mi * 65536, 256, 256, GwT, nullptr, 1, blk * 512 + g * 128, 1 << 30, scr, r % I_G1, lane); continue; } r -= I_G;
            if (r < I_SQ) { transpose_item(p.lru_w_out, D, D, WoutT, nullptr, 0, 0, 0, scr, r, lane); continue; } r -= I_SQ;
            if (r < I_QKV) { transpose_item(p.attn_w_qkv, D, NQKV, WqkvT, p.mix_norm + D, 0, 0, 0, scr, r, lane); continue; } r -= I_QKV;
            if (r < I_SQ) { transpose_item(p.attn_w_o, D, D, WoT, nullptr, 0, 0, 0, scr, r, lane); continue; } r -= I_SQ;
            if (r < 2 * I_W1) { const int l = r / I_W1; transpose_item(p.ffn_w_in + (size_t)l * D * NFF2, D, NFF2, W1T + (size_t)l * NFF2 * D, p.ffn_norm + l * D, 1, 0, FF, scr, r % I_W1, lane); continue; } r -= 2 * I_W1;
            { const int l = r / I_W2; transpose_item(p.ffn_w_out + (size_t)l * FF * D, FF, D, W2T + (size_t)l * D * FF, nullptr, 0, 0, 0, scr, r % I_W2, lane); }
        }
        for (int m = gw; m < M; m += NGW) rms_row_to_bf16(p.x + (size_t)m * D, p.mix_norm, XN0 + (size_t)m * D, lane);
        if (gt < D) CN[gt] = -8.0f * log1pf(expf(-p.lru_lambda[gt]));
    }
    grid.sync();

    {
        pg8::Gemm g{XN0, WinT, M, NLRU2, D}; pg8::StaticOrder S; S.init(M, NLRU2, G, bx);
        pg8::EpiLruIn E{GB, RP, p.lru_b_in};
        pg8::gemm_phase<pg8::EpiLruIn, pg8::StaticOrder, true, true>(lds, g, S, E);
    }
    grid.sync();

    {
        for (int it = gt; it < (M / 8) * 128; it += NGT) {
            const int cc = it & 127, tg = it >> 7; const int row0 = tg * 8, t0 = row0 & (SEQ - 1), ch = cc * 8;
            float wk[4][8], bia[8];
#pragma unroll
            for (int k = 0; k < 4; ++k) { const f32x4 a = *(const f32x4*)(p.lru_conv_w + k * D + ch), b = *(const f32x4*)(p.lru_conv_w + k * D + ch + 4);
                wk[k][0] = a.x; wk[k][1] = a.y; wk[k][2] = a.z; wk[k][3] = a.w; wk[k][4] = b.x; wk[k][5] = b.y; wk[k][6] = b.z; wk[k][7] = b.w; }
            { const f32x4 a = *(const f32x4*)(p.lru_conv_b + ch), b = *(const f32x4*)(p.lru_conv_b + ch + 4); bia[0] = a.x; bia[1] = a.y; bia[2] = a.z; bia[3] = a.w; bia[4] = b.x; bia[5] = b.y; bia[6] = b.z; bia[7] = b.w; }
            v4u win[11];
#pragma unroll
            for (int i = 0; i < 11; ++i) { const int t = t0 - 3 + i; win[i] = (t >= 0) ? *(const v4u*)(RP + (size_t)(row0 - 3 + i) * D + ch) : (v4u){0u, 0u, 0u, 0u}; }
            bf16* dst = REC + ((size_t)(cc >> 5) * M + row0) * 256 + (cc & 31) * 8;
#pragma unroll
            for (int j = 0; j < 8; ++j) {
                float acc[8];
#pragma unroll
                for (int e = 0; e < 8; ++e) acc[e] = bia[e];
#pragma unroll
                for (int k = 0; k < 4; ++k) { const v4u x = win[j + k];
                    acc[0] += wk[k][0] * bflo(x.x); acc[1] += wk[k][1] * bfhi(x.x); acc[2] += wk[k][2] * bflo(x.y); acc[3] += wk[k][3] * bfhi(x.y);
                    acc[4] += wk[k][4] * bflo(x.z); acc[5] += wk[k][5] * bfhi(x.z); acc[6] += wk[k][6] * bflo(x.w); acc[7] += wk[k][7] * bfhi(x.w); }
                v4u o; o.x = pk2(acc[0], acc[1]); o.y = pk2(acc[2], acc[3]); o.z = pk2(acc[4], acc[5]); o.w = pk2(acc[6], acc[7]);
                *(v4u*)(dst + (size_t)j * 256) = o; }
        }
    }
    grid.sync();

    {
        pg8::Gemm g{REC, GwT, 4 * M, 512, 256}; pg8::GateOrder S; S.base.init(4 * M, 512, G, bx);
        pg8::EpiGate E{REC, p.lru_gate_b, CN, Aa, Ba, M};
        pg8::gemm_phase<pg8::EpiGate, pg8::GateOrder, true, true>(lds, g, S, E);
    }
    grid.sync();

    {
        for (int it = vcu; it < BATCH * 32; it += G) {
            const int b = it >> 5, c = ((it & 31) << 1) + (tid >> 8), ch = (tid & 255) * 4;
            const size_t base = ((size_t)b * SEQ + (size_t)c * 64) * D + ch;
            f32x4 Ap = {1.f, 1.f, 1.f, 1.f}, Hh = {0.f, 0.f, 0.f, 0.f};
#pragma unroll 8
            for (int t = 0; t < 64; ++t) { const f32x4 a = *(const f32x4*)(Aa + base + (size_t)t * D), bb = *(const f32x4*)(Ba + base + (size_t)t * D); Hh = a * Hh + bb; Ap = Ap * a; }
            const size_t ao = ((size_t)b * 64 + c) * D + ch; *(f32x4*)(AGGA + ao) = Ap; *(f32x4*)(AGGB + ao) = Hh;
        }
    }
    grid.sync();
    {
        for (int it = vcu; it < BATCH * 32; it += G) {
            const int b = it >> 5, c = ((it & 31) << 1) + (tid >> 8), ch = (tid & 255) * 4;
            f32x4 Hh = {0.f, 0.f, 0.f, 0.f};
            for (int cc = 0; cc < c; ++cc) { const size_t ao = ((size_t)b * 64 + cc) * D + ch; Hh = *(const f32x4*)(AGGA + ao) * Hh + *(const f32x4*)(AGGB + ao); }
            const size_t base = ((size_t)b * SEQ + (size_t)c * 64) * D + ch;
#pragma unroll 8
            for (int t = 0; t < 64; ++t) { const size_t o = base + (size_t)t * D; const f32x4 a = *(const f32x4*)(Aa + o), bb = *(const f32x4*)(Ba + o); Hh = a * Hh + bb;
                const v2u g = *(const v2u*)(GB + o); v2u y; y.x = pk2(bflo(g.x) * Hh.x, bfhi(g.x) * Hh.y); y.y = pk2(bflo(g.y) * Hh.z, bfhi(g.y) * Hh.w); *(v2u*)(Y + o) = y; }
        }
    }
    grid.sync();

    {
        pg8::Gemm g{Y, WoutT, M, D, D}; pg8::StaticOrder S; S.init(M, D, G, bx);
        pg8::EpiResid E{p.x, H, HB, SS, p.lru_b_out};
        pg8::gemm_phase<pg8::EpiResid, pg8::StaticOrder, true, true>(lds, g, S, E);
    }
    grid.sync();
    {
        pg8::Gemm g{HB, W1T, M, NFF2, D}; pg8::StaticOrder S; S.init(M, NFF2, G, bx);
        pg8::EpiSwiglu E{SS, HID, FF};
        pg8::gemm_phase<pg8::EpiSwiglu, pg8::StaticOrder, true, true>(lds, g, S, E);
    }
    grid.sync();
    {
        pg8::Gemm g{HID, W2T, M, D, FF}; pg8::StaticOrder S; S.init(M, D, G, bx);
        pg8::EpiResid E{H, H, HB, SS + SS_STRIDE, nullptr};
        pg8::gemm_phase<pg8::EpiResid, pg8::StaticOrder, true, true>(lds, g, S, E);
    }
    grid.sync();
    {
        pg8::Gemm g{HB, WqkvT, M, NQKV, D}; pg8::StaticOrder S; S.init(M, NQKV, G, bx);
        static_assert(WS_V - WS_K == WS_K - WS_Q, "Q|K|V equally spaced");
        pg8::EpiQKV E{SS + SS_STRIDE, Qb, (size_t)(WS_K - WS_Q) / 2, 0.125f * 1.4426950408889634f};
        pg8::gemm_phase<pg8::EpiQKV, pg8::StaticOrder, true, true>(lds, g, S, E);
    }
    grid.sync();
    sba::attn_phase(vcu, G, Qb, Kb, Vb, Ob, lds);
    grid.sync();
    {
        pg8::Gemm g{Ob, WoT, M, D, D}; pg8::StaticOrder S; S.init(M, D, G, bx);
        pg8::EpiResid E{H, H, HB, SS + 2 * SS_STRIDE, nullptr};
        pg8::gemm_phase<pg8::EpiResid, pg8::StaticOrder, true, true>(lds, g, S, E);
    }
    grid.sync();
    {
        pg8::Gemm g{HB, W1T + (size_t)NFF2 * D, M, NFF2, D}; pg8::StaticOrder S; S.init(M, NFF2, G, bx);
        pg8::EpiSwiglu E{SS + 2 * SS_STRIDE, HID, FF};
        pg8::gemm_phase<pg8::EpiSwiglu, pg8::StaticOrder, true, true>(lds, g, S, E);
    }
    grid.sync();
    {
        pg8::Gemm g{HID, W2T + (size_t)D * FF, M, D, FF}; pg8::StaticOrder S; S.init(M, D, G, bx);
        pg8::EpiResid E{H, p.out, nullptr, SS + 3 * SS_STRIDE, nullptr};
        pg8::gemm_phase<pg8::EpiResid, pg8::StaticOrder, true, true>(lds, g, S, E);
    }
    grid.sync();
    for (int m = gw; m < M; m += NGW) rms_row_f32(p.out + (size_t)m * D, p.final_norm, lane);
}

extern "C" void kernel_launch(void* const* d_in, const int* in_sizes, int n_in, void* d_out, int out_size, void* d_ws, size_t ws_size, hipStream_t stream) {
    static int grid = 0;
    if (grid == 0) {
        if (n_in != 17 || in_sizes[0] != M * D || out_size != M * D || ws_size < WS_END) { fprintf(stderr, "kernel_launch: unexpected shapes (n_in %d, in0 %d, out %d, ws %zu)\n", n_in, n_in > 0 ? in_sizes[0] : -1, out_size, ws_size); grid = -1; return; }
        int dev = 0, cus = 0, per_cu = 0;
        if (hipGetDevice(&dev) != hipSuccess || hipDeviceGetAttribute(&cus, hipDeviceAttributeMultiprocessorCount, dev) != hipSuccess) { grid = -1; return; }
        if (hipFuncSetAttribute((const void*)hybrid_fwd, hipFuncAttributeMaxDynamicSharedMemorySize, LDS_BYTES) != hipSuccess) { fprintf(stderr, "kernel_launch: hipFuncSetAttribute failed\n"); grid = -1; return; }
        if (hipOccupancyMaxActiveBlocksPerMultiprocessor(&per_cu, (const void*)hybrid_fwd, NTHREADS, LDS_BYTES) != hipSuccess || per_cu < 1) { fprintf(stderr, "kernel_launch: occupancy query says %d\n", per_cu); per_cu = 1; }
        (void)hipGetLastError();
        grid = cus;
    }
    if (grid < 0) return;
    Params p{};
    p.x = (const float*)d_in[0]; p.mix_norm = (const float*)d_in[1]; p.ffn_norm = (const float*)d_in[2]; p.final_norm = (const float*)d_in[3];
    p.lru_w_in = (const float*)d_in[4]; p.lru_b_in = (const float*)d_in[5]; p.lru_conv_w = (const float*)d_in[6]; p.lru_conv_b = (const float*)d_in[7];
    p.lru_gate_w = (const float*)d_in[8]; p.lru_gate_b = (const float*)d_in[9]; p.lru_lambda = (const float*)d_in[10]; p.lru_w_out = (const float*)d_in[11]; p.lru_b_out = (const float*)d_in[12];
    p.attn_w_qkv = (const float*)d_in[13]; p.attn_w_o = (const float*)d_in[14]; p.ffn_w_in = (const float*)d_in[15]; p.ffn_w_out = (const float*)d_in[16];
    p.out = (float*)d_out; p.ws = (unsigned char*)d_ws;
    void* args[] = {&p};
    hipError_t e = hipLaunchCooperativeKernel((const void*)hybrid_fwd, dim3(grid), dim3(NTHREADS), args, LDS_BYTES, stream);
    if (e != hipSuccess) fprintf(stderr, "kernel_launch: cooperative launch failed: %s (grid %d)\n", hipGetErrorString(e), grid);
}
```

```cpp
#include <hip/hip_runtime.h>
#include <hip/hip_cooperative_groups.h>
#include <cstdio>
#include <cstdint>
namespace cg = cooperative_groups;
namespace pg8 {
#define PG8_LAS __attribute__((address_space(3)))
typedef unsigned short bf16_t;
typedef short bf16x8 __attribute__((ext_vector_type(8)));
typedef float f32x4 __attribute__((ext_vector_type(4)));
typedef unsigned u32x4 __attribute__((ext_vector_type(4)));
constexpr int BM = 256, BK = 64, HALF = 128, HTB = HALF * BK * 2  , STAGE_BYTES = 8 * HTB, NXCD = 8, WGM = 8;

__host__ __device__ __forceinline__ int lds_byte(int r, int c) { const int st = (r >> 4) * 2 + (c >> 5), rr = r & 15, cc = c & 31, ob = rr * 64 + cc * 2; return st * 1024 + (ob ^ (((ob >> 9) & 1) << 5)); }
__host__ __device__ __forceinline__ void stage_rc(int b, int& R, int& C) { const int st = b / 1024, sb = b % 1024, swz = sb ^ (((sb >> 9) & 1) << 5); R = (st >> 1) * 16 + swz / 64; C = (st & 1) * 32 + (swz % 64) / 2; }
__host__ __device__ __forceinline__ int perm32(int rho) { const int n = rho >> 4, i = rho & 15; return 8 * (i >> 2) + 4 * n + (i & 3); }

struct Unit { int pm, pn; };
struct Gemm { const bf16_t* A; const bf16_t* Bt; int M, N, K; };

struct StaticOrder {
    int nM, nN, nwg, G, c;
    __host__ __device__ void init(int M, int N, int G_, int c_) { nM = M / BM; nN = N / BM; nwg = nM * nN; G = G_; c = c_; }
    __host__ __device__ bool next(int i, Unit& u) const {
        const long L = (long)i * G + c; if (L >= nwg) return false;
        int wgid = (int)L; { const int q = nwg / NXCD, r = nwg % NXCD, xcd = wgid % NXCD, off = wgid / NXCD; wgid = (xcd < r ? xcd * (q + 1) : r * (q + 1) + (xcd - r) * q) + off; }
        const int nig = WGM * nN, gid = wgid / nig, fm = gid * WGM, gsz = (nM - fm) < WGM ? (nM - fm) : WGM;
        u.pm = fm + ((wgid % nig) % gsz); u.pn = (wgid % nig) / gsz; return true;
    }
    __device__ __forceinline__ void a_ready(const Unit&) const {}
    __device__ __forceinline__ void done(const Unit&) const {}
};

__device__ __forceinline__ unsigned cvt_pk_bf16(float lo, float hi) { unsigned r; asm volatile("v_cvt_pk_bf16_f32 %0, %1, %2" : "=v"(r) : "v"(lo), "v"(hi)); return r; }
typedef float f32x2 __attribute__((ext_vector_type(2)));
template <class Epi, class Sched, bool ALIGN_EPI = false, bool SP2 = false>
__device__ __forceinline__ void gemm_phase(PG8_LAS unsigned char* lds, const Gemm g, const Sched& S, const Epi& E) {
    const int tid = threadIdx.x, wid = __builtin_amdgcn_readfirstlane(tid >> 6), lane = tid & 63, wr = wid >> 2, wc = wid & 3, fr = lane & 15, fq = lane >> 4;
    int Kx_ = g.K; asm volatile("" : "+s"(Kx_)); const int K = Kx_, nt = K / BK;
    unsigned voffA[2], voffB[2];
#pragma unroll
    for (int i = 0; i < 2; ++i) { int R, C; stage_rc(tid * 16 + i * 8192, R, C); const int Rb = Epi::PERM ? ((R & ~31) + perm32(R & 31)) : R;
        voffA[i] = (unsigned)(R * K + C) * 2u; voffB[i] = (unsigned)(Rb * K + C) * 2u; }
    const size_t kstep = (size_t)(BK * 2);
    const size_t hstep = (size_t)HALF * K * 2;
    const size_t tstep = 2 * hstep;
    const unsigned ldsw = (unsigned)wid * 1024u;
    const int aoff = lds_byte(wr * 64 + fr, fq * 8), boff = lds_byte(wc * 32 + fr, fq * 8);
#define PG8_SA(b, h) (((b) * 2 + (h)) * HTB)
#define PG8_SB(b, h) ((4 + (b) * 2 + (h)) * HTB)
#define PG8_STAGE(bufoff, gbase, voff) do { _Pragma("unroll") for (int _i = 0; _i < 2; ++_i) \
        __builtin_amdgcn_global_load_lds((const unsigned*)((const char*)(gbase) + (voff)[_i]), (PG8_LAS unsigned*)(lds + (bufoff) + ldsw + _i * 8192), 16, 0, 0); } while (0)
#define PG8_LDA(dst, b, h) do { _Pragma("unroll") for (int m = 0; m < 4; ++m) _Pragma("unroll") for (int k = 0; k < 2; ++k) dst[m][k] = *(const PG8_LAS bf16x8*)(lds + PG8_SA(b, h) + aoff + m * 2048 + k * 1024); } while (0)
#define PG8_LDB(dst, b, h) do { _Pragma("unroll") for (int n = 0; n < 2; ++n) _Pragma("unroll") for (int k = 0; k < 2; ++k) dst[n][k] = *(const PG8_LAS bf16x8*)(lds + PG8_SB(b, h) + boff + n * 2048 + k * 1024); } while (0)
#define PG8_MMA(ai, bj, At, Bt) do { __builtin_amdgcn_s_setprio(1); _Pragma("unroll") for (int m = 0; m < 4; ++m) _Pragma("unroll") for (int n = 0; n < 2; ++n) _Pragma("unroll") for (int k = 0; k < 2; ++k) \
        acc[ai][bj][m][n] = __builtin_amdgcn_mfma_f32_16x16x32_bf16(Bt[n][k], At[m][k], acc[ai][bj][m][n], 0, 0, 0); __builtin_amdgcn_s_setprio(0); } while (0)
#define PG8_WAIT_V(n) asm volatile("s_waitcnt vmcnt(" #n ")" ::: "memory")
#define PG8_WAIT_L(n) asm volatile("s_waitcnt lgkmcnt(" #n ")" ::: "memory")
#define PG8_BAR __builtin_amdgcn_s_barrier()
#define PG8_SCHED __builtin_amdgcn_sched_barrier(0)
    Unit cur, nxt; int ui = 0;
    if (!S.next(0, cur)) return;
    f32x4 acc[2][2][4][2];
#pragma unroll
    for (int a = 0; a < 2; ++a)
#pragma unroll
        for (int b = 0; b < 2; ++b)
#pragma unroll
            for (int m = 0; m < 4; ++m)
#pragma unroll
                for (int n = 0; n < 2; ++n) acc[a][b][m][n] = (f32x4){0.f, 0.f, 0.f, 0.f};
    bf16x8 At[4][2], B0[2][2], B1[2][2];
    const char* cA = (const char*)g.A + (size_t)cur.pm * tstep; const char* cB = (const char*)g.Bt + (size_t)cur.pn * tstep;
    S.a_ready(cur);
    if constexpr (SP2) {
        PG8_STAGE(PG8_SB(0, 0), cB, voffB); PG8_STAGE(PG8_SB(0, 1), cB + hstep, voffB); PG8_STAGE(PG8_SA(0, 0), cA, voffA); PG8_STAGE(PG8_SA(0, 1), cA + hstep, voffA);
        if (wr == 1) PG8_BAR;
        PG8_WAIT_V(2); PG8_BAR;
        PG8_STAGE(PG8_SB(1, 0), cB + kstep, voffB); PG8_STAGE(PG8_SA(1, 0), cA + kstep, voffA); PG8_STAGE(PG8_SB(1, 1), cB + hstep + kstep, voffB);
        PG8_WAIT_V(6); PG8_BAR;
    } else {
        PG8_STAGE(PG8_SB(0, 0), cB, voffB); PG8_STAGE(PG8_SA(0, 0), cA, voffA); PG8_STAGE(PG8_SB(0, 1), cB + hstep, voffB); PG8_STAGE(PG8_SA(0, 1), cA + hstep, voffA);
        if (wr == 1) PG8_BAR;
        PG8_WAIT_V(4); PG8_BAR;
        PG8_STAGE(PG8_SB(1, 0), cB + kstep, voffB); PG8_STAGE(PG8_SA(1, 0), cA + kstep, voffA); PG8_STAGE(PG8_SB(1, 1), cB + hstep + kstep, voffB);
        PG8_WAIT_V(6); PG8_BAR;
    }
    for (;;) {
        const bool has_next = S.next(ui + 1, nxt);
        const char* nA = has_next ? (const char*)g.A + (size_t)nxt.pm * tstep : cA; const char* nB = has_next ? (const char*)g.Bt + (size_t)nxt.pn * tstep : cB;
        for (int t = 0; t < nt; t += 2) {
            const bool last = (t == nt - 2);
            const char* a1 = cA + (size_t)(t + 1) * kstep;
            const char* a2 = last ? nA : cA + (size_t)(t + 2) * kstep; const char* b2 = last ? nB : cB + (size_t)(t + 2) * kstep;
            const char* a3 = a2 + kstep; const char* b3 = b2 + kstep;
            if (last && has_next) S.a_ready(nxt);
            if constexpr (SP2) {
            PG8_LDB(B0, 0, 0); PG8_LDB(B1, 0, 1); PG8_SCHED; PG8_LDA(At, 0, 0); PG8_STAGE(PG8_SA(1, 1), a1 + hstep, voffA);
            PG8_WAIT_V(8); PG8_WAIT_L(0); PG8_BAR; PG8_MMA(0, 0, At, B0); PG8_MMA(0, 1, At, B1); PG8_BAR; PG8_SCHED;
            PG8_LDA(At, 0, 1); PG8_STAGE(PG8_SB(0, 0), b2, voffB); PG8_STAGE(PG8_SB(0, 1), b2 + hstep, voffB); PG8_STAGE(PG8_SA(0, 0), a2, voffA);
            PG8_WAIT_V(8); PG8_WAIT_L(0); PG8_BAR; PG8_MMA(1, 0, At, B0); PG8_MMA(1, 1, At, B1); PG8_BAR; PG8_SCHED;
            PG8_LDB(B0, 1, 0); PG8_LDB(B1, 1, 1); PG8_SCHED; PG8_LDA(At, 1, 0); PG8_STAGE(PG8_SA(0, 1), a2 + hstep, voffA);
            PG8_WAIT_V(8); PG8_WAIT_L(0); PG8_BAR; PG8_MMA(0, 0, At, B0); PG8_MMA(0, 1, At, B1); PG8_BAR; PG8_SCHED;
            PG8_LDA(At, 1, 1); PG8_STAGE(PG8_SB(1, 0), b3, voffB); PG8_STAGE(PG8_SB(1, 1), b3 + hstep, voffB); PG8_STAGE(PG8_SA(1, 0), a3, voffA);
            PG8_WAIT_V(8); PG8_WAIT_L(0); PG8_BAR; PG8_MMA(1, 0, At, B0); PG8_MMA(1, 1, At, B1); PG8_BAR; PG8_SCHED;
            } else {
            PG8_LDB(B0, 0, 0); PG8_SCHED; PG8_LDA(At, 0, 0); PG8_STAGE(PG8_SA(1, 1), a1 + hstep, voffA);
            PG8_WAIT_L(8); PG8_BAR; PG8_WAIT_L(0); PG8_MMA(0, 0, At, B0); PG8_BAR; PG8_SCHED;
            PG8_LDB(B1, 0, 1); PG8_STAGE(PG8_SB(0, 0), b2, voffB);
            PG8_BAR; PG8_WAIT_L(0); PG8_MMA(0, 1, At, B1); PG8_BAR;
            PG8_LDA(At, 0, 1); PG8_STAGE(PG8_SA(0, 0), a2, voffA);
            PG8_BAR; PG8_WAIT_L(0); PG8_MMA(1, 0, At, B0); PG8_BAR; PG8_SCHED;
            PG8_STAGE(PG8_SB(0, 1), b2 + hstep, voffB);
            PG8_WAIT_V(6); PG8_BAR; PG8_MMA(1, 1, At, B1); PG8_BAR;
            PG8_LDB(B0, 1, 0); PG8_SCHED; PG8_LDA(At, 1, 0); PG8_STAGE(PG8_SA(0, 1), a2 + hstep, voffA);
            PG8_WAIT_L(8); PG8_BAR; PG8_WAIT_L(0); PG8_MMA(0, 0, At, B0); PG8_BAR; PG8_SCHED;
            PG8_LDB(B1, 1, 1); PG8_STAGE(PG8_SB(1, 0), b3, voffB);
            PG8_BAR; PG8_WAIT_L(0); PG8_MMA(0, 1, At, B1); PG8_BAR;
            PG8_LDA(At, 1, 1); PG8_STAGE(PG8_SA(1, 0), a3, voffA);
            PG8_BAR; PG8_WAIT_L(0); PG8_MMA(1, 0, At, B0); PG8_BAR; PG8_SCHED;
            PG8_STAGE(PG8_SB(1, 1), b3 + hstep, voffB);
            PG8_WAIT_V(6); PG8_BAR; PG8_MMA(1, 1, At, B1); PG8_BAR;
            }
        }
        if constexpr (ALIGN_EPI) { if (wr == 0) PG8_BAR; }
        if constexpr (!Epi::AFTER_DRAIN) { E(acc, cur, wr, wc, fr, fq); S.done(cur); }
        if (!has_next) break;
#pragma unroll
        for (int a = 0; a < 2; ++a)
#pragma unroll
            for (int b = 0; b < 2; ++b)
#pragma unroll
                for (int m = 0; m < 4; ++m)
#pragma unroll
                    for (int n = 0; n < 2; ++n) acc[a][b][m][n] = (f32x4){0.f, 0.f, 0.f, 0.f};
        cur = nxt; cA = nA; cB = nB; ++ui;
        if constexpr (ALIGN_EPI) { if (wr == 1) PG8_BAR; }
    }
    PG8_WAIT_V(0);
    if constexpr (!ALIGN_EPI) { if (wr == 0) PG8_BAR; }
    PG8_BAR;
    if constexpr (Epi::AFTER_DRAIN) { E.fused(acc, cur, wr, wc, fr, fq, lds, wid, lane); S.done(cur); }
#undef PG8_SA
#undef PG8_SB
#undef PG8_STAGE
#undef PG8_LDA
#undef PG8_LDB
#undef PG8_MMA
#undef PG8_WAIT_V
#undef PG8_WAIT_L
#undef PG8_BAR
#undef PG8_SCHED
}
}
namespace pg8 {
typedef unsigned u32x2 __attribute__((ext_vector_type(2)));
__device__ __forceinline__ float bf_lo(unsigned w) { return __uint_as_float(w << 16); }
__device__ __forceinline__ float bf_hi(unsigned w) { return __uint_as_float(w & 0xffff0000u); }
__device__ __forceinline__ float fast_sigmoid(float x) { return __builtin_amdgcn_rcpf(1.0f + __builtin_amdgcn_exp2f(-1.4426950408889634f * x)); }
__device__ __forceinline__ float gelu_tanh(float x) {
    const float u2 = 1.5957691216057308f * (x + 0.044715f * x * x * x);
    return x * fast_sigmoid(u2);
}
__device__ __forceinline__ u32x4 pack8(const f32x4 a, const f32x4 b) { u32x4 w; w.x = cvt_pk_bf16(a[0], a[1]); w.y = cvt_pk_bf16(a[2], a[3]); w.z = cvt_pk_bf16(b[0], b[1]); w.w = cvt_pk_bf16(b[2], b[3]); return w; }
constexpr float RMS_EPS = 1e-6f;
__device__ __forceinline__ float row_rstd(const float* ss, int row) {
    const f32x4* p = (const f32x4*)(ss + (size_t)row * 16); const f32x4 a = p[0], b = p[1], c = p[2], d = p[3];
    const float s = ((a[0] + a[1]) + (a[2] + a[3])) + ((b[0] + b[1]) + (b[2] + b[3])) + ((c[0] + c[1]) + (c[2] + c[3])) + ((d[0] + d[1]) + (d[2] + d[3]));
    return __builtin_amdgcn_rsqf(s * (1.0f / 1024.0f) + RMS_EPS);
}

__device__ __forceinline__ void wave_rstd8(const float* ss, int wave_row0  , int lane, int fr, float (&rs)[2][4]) {
    const f32x4* p0 = (const f32x4*)(ss + (size_t)(wave_row0 + lane) * 16); const f32x4* p1 = (const f32x4*)(ss + (size_t)(wave_row0 + HALF + lane) * 16);
    const f32x4 a0 = p0[0], b0 = p0[1], c0 = p0[2], d0 = p0[3], a1 = p1[0], b1 = p1[1], c1 = p1[2], d1 = p1[3];
    const float s0 = ((a0[0] + a0[1]) + (a0[2] + a0[3])) + ((b0[0] + b0[1]) + (b0[2] + b0[3])) + ((c0[0] + c0[1]) + (c0[2] + c0[3])) + ((d0[0] + d0[1]) + (d0[2] + d0[3]));
    const float s1 = ((a1[0] + a1[1]) + (a1[2] + a1[3])) + ((b1[0] + b1[1]) + (b1[2] + b1[3])) + ((c1[0] + c1[1]) + (c1[2] + c1[3])) + ((d1[0] + d1[1]) + (d1[2] + d1[3]));
    const float v0 = __builtin_amdgcn_rsqf(s0 * (1.0f / 1024.0f) + RMS_EPS), v1 = __builtin_amdgcn_rsqf(s1 * (1.0f / 1024.0f) + RMS_EPS);
#pragma unroll
    for (int m = 0; m < 4; ++m) { rs[0][m] = __shfl(v0, m * 16 + fr); rs[1][m] = __shfl(v1, m * 16 + fr); }
}

struct EpiLruIn {
    static constexpr bool PERM = true, AFTER_DRAIN = false;
    bf16_t* GB; bf16_t* RP; const float* bias;
    __device__ __forceinline__ void operator()(const f32x4 (&acc)[2][2][4][2], const Unit& u, int wr, int wc, int fr, int fq) const {
        const int row0 = u.pm * BM + wr * 64 + fr; const bool gate = u.pn < 4;
        const int colg = u.pn * BM + wc * 32 + 8 * fq; bf16_t* base = gate ? GB : RP; const int col0 = gate ? colg : colg - 1024;
        f32x4 bv[2][2];
#pragma unroll
        for (int bj = 0; bj < 2; ++bj)
#pragma unroll
            for (int n = 0; n < 2; ++n) bv[bj][n] = *(const f32x4*)(bias + colg + bj * HALF + 4 * n);
#pragma unroll
        for (int ai = 0; ai < 2; ++ai)
#pragma unroll
            for (int m = 0; m < 4; ++m) { bf16_t* rowp = base + (size_t)(row0 + ai * HALF + m * 16) * 1024 + col0;
#pragma unroll
                for (int bj = 0; bj < 2; ++bj) { f32x4 v0 = acc[ai][bj][m][0] + bv[bj][0], v1 = acc[ai][bj][m][1] + bv[bj][1];
                    if (gate) {
                        constexpr float k1 = -1.4426950408889634f * 1.5957691216057308f, k2 = k1 * 0.044715f;
                        const f32x4 t0 = v0 * (v0 * v0 * k2 + k1), t1 = v1 * (v1 * v1 * k2 + k1);
                        const f32x4 d0 = (f32x4){__builtin_amdgcn_exp2f(t0[0]), __builtin_amdgcn_exp2f(t0[1]), __builtin_amdgcn_exp2f(t0[2]), __builtin_amdgcn_exp2f(t0[3])} + 1.0f;
                        const f32x4 d1 = (f32x4){__builtin_amdgcn_exp2f(t1[0]), __builtin_amdgcn_exp2f(t1[1]), __builtin_amdgcn_exp2f(t1[2]), __builtin_amdgcn_exp2f(t1[3])} + 1.0f;
                        v0 = v0 * (f32x4){__builtin_amdgcn_rcpf(d0[0]), __builtin_amdgcn_rcpf(d0[1]), __builtin_amdgcn_rcpf(d0[2]), __builtin_amdgcn_rcpf(d0[3])};
                        v1 = v1 * (f32x4){__builtin_amdgcn_rcpf(d1[0]), __builtin_amdgcn_rcpf(d1[1]), __builtin_amdgcn_rcpf(d1[2]), __builtin_amdgcn_rcpf(d1[3])}; }
                    *(u32x4*)(rowp + bj * HALF) = pack8(v0, v1); } }
    }
};

struct EpiGate {
    static constexpr bool PERM = true, AFTER_DRAIN = false;
    const bf16_t* REC; const float* gate_b; const float* cn_tab; unsigned* AB; int M;
    __device__ __forceinline__ void operator()(const f32x4 (&acc)[2][2][4][2], const Unit& u, int wr, int wc, int fr, int fq) const {
        const int blk = u.pn >> 1, half = u.pn & 1;
        const int cl = half * 128 + wc * 32 + 8 * fq;
        const int ch0 = blk * 256 + cl;
        const int rowA0 = u.pm * BM + wr * 64 + fr;
        u32x4 rw[2][4];
#pragma unroll
        for (int ai = 0; ai < 2; ++ai)
#pragma unroll
            for (int m = 0; m < 4; ++m) rw[ai][m] = *(const u32x4*)(REC + (size_t)(rowA0 + ai * HALF + m * 16) * 256 + cl);
        f32x4 cn[2], gr[2], gi[2];
#pragma unroll
        for (int n = 0; n < 2; ++n) { cn[n] = *(const f32x4*)(cn_tab + ch0 + 4 * n); gr[n] = *(const f32x4*)(gate_b + ch0 + 4 * n); gi[n] = *(const f32x4*)(gate_b + 1024 + ch0 + 4 * n); }
#pragma unroll
        for (int ai = 0; ai < 2; ++ai)
#pragma unroll
            for (int m = 0; m < 4; ++m) {
                const int rowA = rowA0 + ai * HALF + m * 16; const int tok = rowA & (M - 1);
                const u32x4 r4 = rw[ai][m];
                const float rec[8] = {bf_lo(r4.x), bf_hi(r4.x), bf_lo(r4.y), bf_hi(r4.y), bf_lo(r4.z), bf_hi(r4.z), bf_lo(r4.w), bf_hi(r4.w)};
                u32x4 o[2];
#pragma unroll
                for (int n = 0; n < 2; ++n)
#pragma unroll
                    for (int e = 0; e < 4; ++e) {
                        const float r = fast_sigmoid(acc[ai][0][m][n][e] + gr[n][e]), ig = fast_sigmoid(acc[ai][1][m][n][e] + gi[n][e]);
                        const float la2 = cn[n][e] * r;
                        const float x = la2 * 1.3862943611198906f;
                        const float pm2 = -x * (1.0f + x * 0.5f * (1.0f + x * (1.0f / 3.0f) * (1.0f + x * 0.25f * (1.0f + x * 0.2f * (1.0f + x * (1.0f / 6.0f))))));
                        const float m2 = (x > -0.35f) ? pm2 : (1.0f - __builtin_amdgcn_exp2f(2.0f * la2));
                        const float bb = __builtin_sqrtf(fmaxf(m2, 0.0f)) * ig * rec[4 * n + e];
                        o[n][e] = cvt_pk_bf16(la2, bb); }
                unsigned* dp = AB + (size_t)tok * 1024 + ch0; *(u32x4*)dp = o[0]; *(u32x4*)(dp + 4) = o[1];
            }
    }
};

template <bool RES_BF16, bool OUT_F32, bool HAS_BIAS = false> struct EpiResid {
    static constexpr bool PERM = true, AFTER_DRAIN = false;
    const void* resid; float* OutF; bf16_t* OutB; float* SS; const float* bias;
    __device__ __forceinline__ void operator()(const f32x4 (&acc)[2][2][4][2], const Unit& u, int wr, int wc, int fr, int fq) const {
        const int row0 = u.pm * BM + wr * 64 + fr; const int col0 = u.pn * BM + wc * 32 + 8 * fq;
        f32x4 bv[2][2];
#pragma unroll
        for (int bj = 0; bj < 2; ++bj)
#pragma unroll
            for (int n = 0; n < 2; ++n) bv[bj][n] = HAS_BIAS ? *(const f32x4*)(bias + col0 + bj * HALF + 4 * n) : (f32x4){0.f, 0.f, 0.f, 0.f};
        constexpr int MG = RES_BF16 ? 2 : 1, NB = 8 / MG;
        u32x4 rb[2][MG][2]; f32x4 rf[2][MG][2][2];
        auto load_batch = [&](int k, int buf) {
#pragma unroll
            for (int mm = 0; mm < MG; ++mm)
#pragma unroll
                for (int bj = 0; bj < 2; ++bj) { const int g = k * MG + mm; const size_t off = (size_t)(row0 + (g >> 2) * HALF + (g & 3) * 16) * 1024 + col0 + bj * HALF;
                    if (RES_BF16) rb[buf][mm][bj] = *(const u32x4*)((const bf16_t*)resid + off);
                    else { rf[buf][mm][bj][0] = *(const f32x4*)((const float*)resid + off); rf[buf][mm][bj][1] = *(const f32x4*)((const float*)resid + off + 4); } } };
        load_batch(0, 0);
#pragma unroll
        for (int k = 0; k < NB; ++k) {
            const int cb = k & 1;
            if (k + 1 < NB) load_batch(k + 1, (k + 1) & 1);
#pragma unroll
            for (int mm = 0; mm < MG; ++mm) { const int g = k * MG + mm, ai = g >> 2, m = g & 3; const int row = row0 + ai * HALF + m * 16; const size_t off = (size_t)row * 1024 + col0; float ssq = 0.f;
#pragma unroll
                for (int bj = 0; bj < 2; ++bj) {
                    f32x4 r0, r1;
                    if (RES_BF16) { const u32x4 rw = rb[cb][mm][bj]; r0 = (f32x4){bf_lo(rw.x), bf_hi(rw.x), bf_lo(rw.y), bf_hi(rw.y)}; r1 = (f32x4){bf_lo(rw.z), bf_hi(rw.z), bf_lo(rw.w), bf_hi(rw.w)}; }
                    else { r0 = rf[cb][mm][bj][0]; r1 = rf[cb][mm][bj][1]; }
                    f32x4 v0 = acc[ai][bj][m][0] + r0, v1 = acc[ai][bj][m][1] + r1;
                    if (HAS_BIAS) { v0 = v0 + bv[bj][0]; v1 = v1 + bv[bj][1]; }
                    if (OUT_F32) { *(f32x4*)(OutF + off + bj * HALF) = v0; *(f32x4*)(OutF + off + bj * HALF + 4) = v1; }
                    else { *(u32x4*)(OutB + off + bj * HALF) = pack8(v0, v1);
                        ssq += (v0[0] * v0[0] + v0[1] * v0[1]) + (v0[2] * v0[2] + v0[3] * v0[3]) + (v1[0] * v1[0] + v1[1] * v1[1]) + (v1[2] * v1[2] + v1[3] * v1[3]); } }
                if (!OUT_F32) {
                    { const auto r = __builtin_amdgcn_permlane16_swap(__float_as_uint(ssq), __float_as_uint(ssq), false, false); ssq = __uint_as_float(r[0]) + __uint_as_float(r[1]); }
                    { const auto r = __builtin_amdgcn_permlane32_swap(__float_as_uint(ssq), __float_as_uint(ssq), false, false); ssq = __uint_as_float(r[0]) + __uint_as_float(r[1]); }
                    if (fq == 0) SS[(size_t)row * 16 + u.pn * 4 + wc] = ssq; } }
        }
    }
};

struct EpiSwiglu {
    static constexpr bool PERM = true, AFTER_DRAIN = false;
    const float* SS; bf16_t* HID; int ldh;
    __device__ __forceinline__ void operator()(const f32x4 (&acc)[2][2][4][2], const Unit& u, int wr, int wc, int fr, int fq) const {
        const int row0 = u.pm * BM + wr * 64 + fr; const int col0 = u.pn * HALF + wc * 32 + 8 * fq;
        float rsv[2][4]; wave_rstd8(SS, u.pm * BM + wr * 64, (int)(threadIdx.x & 63), fr, rsv);
#pragma unroll
        for (int ai = 0; ai < 2; ++ai)
#pragma unroll
            for (int m = 0; m < 4; ++m) { const int row = row0 + ai * HALF + m * 16; const float rs = rsv[ai][m];
                const float nrs = -1.4426950408889634f * rs, rsq = rs * rs;
                f32x4 h[2];
#pragma unroll
                for (int n = 0; n < 2; ++n) { const f32x4 g = acc[ai][0][m][n], up = acc[ai][1][m][n]; const f32x4 t = g * nrs;
                    f32x4 d = (f32x4){__builtin_amdgcn_exp2f(t[0]), __builtin_amdgcn_exp2f(t[1]), __builtin_amdgcn_exp2f(t[2]), __builtin_amdgcn_exp2f(t[3])} + 1.0f;
                    const f32x4 sg = (f32x4){__builtin_amdgcn_rcpf(d[0]), __builtin_amdgcn_rcpf(d[1]), __builtin_amdgcn_rcpf(d[2]), __builtin_amdgcn_rcpf(d[3])};
                    h[n] = ((g * up) * rsq) * sg; }
                *(u32x4*)(HID + (size_t)row * ldh + col0) = pack8(h[0], h[1]); }
    }
};

struct EpiQKV {
    static constexpr bool PERM = true, AFTER_DRAIN = false;
    const float* SS; bf16_t* Q; size_t tstride; float qscale;
    __device__ __forceinline__ void operator()(const f32x4 (&acc)[2][2][4][2], const Unit& u, int wr, int wc, int fr, int fq) const {
        const int row0 = u.pm * BM + wr * 64 + fr; const int t = u.pn >> 2; const int col0 = (u.pn & 3) * BM + wc * 32 + 8 * fq;
        bf16_t* base = Q + (size_t)t * tstride; const float sc = t == 0 ? qscale : 1.0f;
        float rsv[2][4]; wave_rstd8(SS, u.pm * BM + wr * 64, (int)(threadIdx.x & 63), fr, rsv);
#pragma unroll
        for (int ai = 0; ai < 2; ++ai)
#pragma unroll
            for (int m = 0; m < 4; ++m) { const int row = row0 + ai * HALF + m * 16; const float rs = rsv[ai][m] * sc;
#pragma unroll
                for (int bj = 0; bj < 2; ++bj) *(u32x4*)(base + (size_t)row * 1024 + col0 + bj * HALF) = pack8(acc[ai][bj][m][0] * rs, acc[ai][bj][m][1] * rs); }
    }
};

struct GateOrder {
    StaticOrder base;
    __device__ bool next(int i, Unit& u) const { if (!base.next(i, u)) return false; u.pn += 2 * (u.pm >> 7); return true; }
    __device__ __forceinline__ void a_ready(const Unit&) const {}
    __device__ __forceinline__ void done(const Unit&) const {}
};
}
namespace sba {
#define SB_LAS __attribute__((address_space(3)))
typedef unsigned short bf16_t;
typedef short bf16x8 __attribute__((ext_vector_type(8)));
typedef short s16x4 __attribute__((ext_vector_type(4)));
typedef float f32x16 __attribute__((ext_vector_type(16)));
typedef unsigned u32x4 __attribute__((ext_vector_type(4)));
typedef unsigned u32x2 __attribute__((ext_vector_type(2)));
constexpr int S = 4096, DM = 1024, PITCH = 144, TILE_B = 64 * PITCH, BUF_B = 2 * TILE_B;
constexpr int NSLOT = 5; constexpr int LDS_BYTES = NSLOT * BUF_B;
__device__ __forceinline__ unsigned cvtpk(float lo, float hi) { unsigned r; asm volatile("v_cvt_pk_bf16_f32 %0, %1, %2" : "=v"(r) : "v"(lo), "v"(hi)); return r; }
__device__ __forceinline__ s16x4 vtr(const SB_LAS unsigned char* p) { return __builtin_bit_cast(s16x4, __builtin_amdgcn_ds_read_tr16_b64_v4i16((SB_LAS s16x4*)p)); }

__device__ __forceinline__ void attn_unit(int b, int h, int qb, const bf16_t* Q, const bf16_t* K, const bf16_t* V, bf16_t* O, SB_LAS unsigned char* lds) {
    const int tid = threadIdx.x, lane = tid & 63, r32 = lane & 31, hi = lane >> 5; const int wid = __builtin_amdgcn_readfirstlane(tid >> 6);
    const size_t rowbase = (size_t)b * S; const int q0 = qb * 256; const int wq0 = q0 + wid * 32; const int qrow = wq0 + r32;
    SB_LAS int* flg = (SB_LAS int*)(lds + LDS_BYTES);
    __syncthreads();
    if (lane == 0) flg[wid] = 0x7fffffff;
    bool wdone = false;
    bf16x8 qf[4];
    { const bf16_t* Qw = Q + (rowbase + qrow) * DM + h * 64;
#pragma unroll
      for (int d0 = 0; d0 < 4; ++d0) qf[d0] = *(const bf16x8*)(Qw + d0 * 16 + hi * 8); }
    const int ldrow = tid >> 3, ldch = tid & 7;
    const bf16_t* kg = K + (rowbase + ldrow) * DM + h * 64 + ldch * 8; const bf16_t* vg = V + (rowbase + ldrow) * DM + h * 64 + ldch * 8;
    const int ldoff = ldrow * PITCH + ldch * 16;
    const int T0 = qb * 4;
    f32x16 o0 = {}, o1 = {}; float C = 1.0f;
    const int trq = (lane & 15) >> 2, trp = lane & 3, trblk = (lane >> 4) & 1;
    const int troff = (4 * hi + trq) * PITCH + (16 * trblk + 4 * trp) * 2;
    const int koff = r32 * PITCH + hi * 16;
    u32x4 kreg, vreg;
    {
        u32x4 k4[4], v4[4];
#pragma unroll
        for (int i = 0; i < 4; ++i) { const size_t go = (size_t)(T0 + i) * 64 * DM; k4[i] = *(const u32x4*)(kg + go); v4[i] = *(const u32x4*)(vg + go); }
#pragma unroll
        for (int i = 0; i < 4; ++i) { SB_LAS unsigned char* sb = lds + ((T0 + i) % NSLOT) * BUF_B; *(SB_LAS u32x4*)(sb + ldoff) = k4[i]; *(SB_LAS u32x4*)(sb + TILE_B + ldoff) = v4[i]; }
    }
    __syncthreads();
    const int pj = wid >> 1;
    for (int k = 0; ; ++k) {
        const int tnew = T0 - k - 1;
        if (tnew >= 0) { const size_t go = (size_t)tnew * 64 * DM; kreg = *(const u32x4*)(kg + go); vreg = *(const u32x4*)(vg + go); }
        const int kt = T0 + pj - k;
        if (!wdone && kt < 0) { wdone = true; if (lane == 0) flg[wid] = k; }
        if (!wdone) {
            const SB_LAS unsigned char* Kb = lds + (kt % NSLOT) * BUF_B; const SB_LAS unsigned char* Vb = Kb + TILE_B;
#pragma unroll
            for (int hf = 1; hf >= 0; --hf) {
                const int kb = 64 * kt + 32 * hf;
                if (kb < wq0 + 31) {
                    f32x16 p = {};
#pragma unroll
                    for (int d0 = 0; d0 < 4; ++d0) { const bf16x8 kf = *(const SB_LAS bf16x8*)(Kb + (32 * hf) * PITCH + koff + d0 * 32); p = __builtin_amdgcn_mfma_f32_32x32x16_bf16(kf, qf[d0], p, 0, 0, 0); }
                    s16x4 va[2][4];
                    { const SB_LAS unsigned char* vb = Vb + (32 * hf) * PITCH + troff;
#pragma unroll
                      for (int ks = 0; ks < 2; ++ks) { va[ks][0] = vtr(vb + (16 * ks) * PITCH); va[ks][1] = vtr(vb + (16 * ks + 8) * PITCH);
                          va[ks][2] = vtr(vb + (16 * ks) * PITCH + 64); va[ks][3] = vtr(vb + (16 * ks + 8) * PITCH + 64); } }
                    __builtin_amdgcn_sched_barrier(0);
                    if (kb + 31 >= wq0) {
                        asm volatile("" ::: "memory");
#pragma unroll
                        for (int r = 0; r < 16; ++r) { const int key = kb + (r & 3) + 8 * (r >> 2) + 4 * hi; if (key >= qrow) p[r] = -INFINITY; }
                    }
                    float dd[16], G[4];
#pragma unroll
                    for (int i = 0; i < 4; ++i) {
                        const float f3 = __builtin_amdgcn_rcpf(1.0f + __builtin_amdgcn_exp2f(p[4 * i + 3])), f2 = __builtin_amdgcn_rcpf(1.0f + __builtin_amdgcn_exp2f(p[4 * i + 2]));
                        const float f1 = __builtin_amdgcn_rcpf(1.0f + __builtin_amdgcn_exp2f(p[4 * i + 1])), f0 = __builtin_amdgcn_rcpf(1.0f + __builtin_amdgcn_exp2f(p[4 * i]));
                        const float L3 = f3, L2 = L3 * f2, L1 = L2 * f1, L0 = L1 * f0;
                        dd[4 * i + 3] = 1.0f - L3; dd[4 * i + 2] = L3 - L2; dd[4 * i + 1] = L2 - L1; dd[4 * i] = L1 - L0; G[i] = L0; }
                    float T[4], Hm[4];
#pragma unroll
                    for (int i = 0; i < 4; ++i) {
                        const auto rr = __builtin_amdgcn_permlane32_swap(__float_as_uint(G[i]), __float_as_uint(G[i]), false, false);
                        const float Lo = __uint_as_float(rr[0]), Hi_ = __uint_as_float(rr[1]); T[i] = Lo * Hi_; Hm[i] = hi ? 1.0f : Hi_; }
                    float Sx[4]; Sx[3] = C; Sx[2] = C * T[3]; Sx[1] = Sx[2] * T[2]; Sx[0] = Sx[1] * T[1];
                    C = Sx[0] * T[0];
                    float w[16];
#pragma unroll
                    for (int i = 0; i < 4; ++i) { const float E = Sx[i] * Hm[i]; w[4 * i + 3] = E * dd[4 * i + 3]; w[4 * i + 2] = E * dd[4 * i + 2]; w[4 * i + 1] = E * dd[4 * i + 1]; w[4 * i] = E * dd[4 * i]; }
                    u32x4 pw0, pw1;
                    pw0.x = cvtpk(w[0], w[1]); pw0.y = cvtpk(w[2], w[3]); pw0.z = cvtpk(w[4], w[5]); pw0.w = cvtpk(w[6], w[7]);
                    pw1.x = cvtpk(w[8], w[9]); pw1.y = cvtpk(w[10], w[11]); pw1.z = cvtpk(w[12], w[13]); pw1.w = cvtpk(w[14], w[15]);
                    const bf16x8 pa0 = __builtin_bit_cast(bf16x8, pw0), pa1 = __builtin_bit_cast(bf16x8, pw1);
#pragma unroll
                    for (int ks = 0; ks < 2; ++ks) {
                        const bf16x8 v0 = (bf16x8){va[ks][0][0], va[ks][0][1], va[ks][0][2], va[ks][0][3], va[ks][1][0], va[ks][1][1], va[ks][1][2], va[ks][1][3]};
                        const bf16x8 v1 = (bf16x8){va[ks][2][0], va[ks][2][1], va[ks][2][2], va[ks][2][3], va[ks][3][0], va[ks][3][1], va[ks][3][2], va[ks][3][3]};
                        o0 = __builtin_amdgcn_mfma_f32_32x32x16_bf16(v0, ks ? pa1 : pa0, o0, 0, 0, 0);
                        o1 = __builtin_amdgcn_mfma_f32_32x32x16_bf16(v1, ks ? pa1 : pa0, o1, 0, 0, 0);
                    }
                }
            }
            if (__builtin_amdgcn_ballot_w64(C != 0.0f) == 0ull) { wdone = true; if (lane == 0) flg[wid] = k; }
        }
        if (tnew >= 0) { SB_LAS unsigned char* nb = lds + (tnew % NSLOT) * BUF_B; *(SB_LAS u32x4*)(nb + ldoff) = kreg; *(SB_LAS u32x4*)(nb + TILE_B + ldoff) = vreg; }
        __syncthreads();
        { typedef int i32x4 __attribute__((ext_vector_type(4))); const i32x4 fa = *(const SB_LAS i32x4*)flg, fb = *(const SB_LAS i32x4*)(flg + 4);
          const int mx = max(max(max(fa.x, fa.y), max(fa.z, fa.w)), max(max(fb.x, fb.y), max(fb.z, fb.w)));
          if (mx <= k) break; }
    }
    { typedef float f32x2_t __attribute__((ext_vector_type(2))); typedef __bf16 bf16x2_t __attribute__((ext_vector_type(2)));
      auto pk = [](float lo, float hi_) -> unsigned { const f32x2_t v = {lo, hi_}; return __builtin_bit_cast(unsigned, __builtin_convertvector(v, bf16x2_t)); };
      bf16_t* Orow = O + (rowbase + qrow) * DM + h * 64 + (hi ? 8 : 0);
#pragma unroll
      for (int dh = 0; dh < 2; ++dh) {
          const f32x16& o = dh ? o1 : o0;
#pragma unroll
          for (int k = 0; k < 4; k += 2) {
              unsigned ax = pk(o[4 * k], o[4 * k + 1]), ay = pk(o[4 * k + 2], o[4 * k + 3]), bx = pk(o[4 * k + 4], o[4 * k + 5]), by = pk(o[4 * k + 6], o[4 * k + 7]);
              { const auto r = __builtin_amdgcn_permlane32_swap(ax, bx, false, false); ax = r[0]; bx = r[1]; }
              { const auto r = __builtin_amdgcn_permlane32_swap(ay, by, false, false); ay = r[0]; by = r[1]; }
              u32x4 w; w.x = ax; w.y = ay; w.z = bx; w.w = by;
              *(u32x4*)(Orow + dh * 32 + 8 * k) = w; } } }
}
__device__ __forceinline__ void attn_phase(int vcu, int G, const bf16_t* Q, const bf16_t* K, const bf16_t* V, bf16_t* O, SB_LAS unsigned char* lds) {
    for (int v = vcu; v < 256; v += G) {
        const int bh = v >> 1, par = v & 1;
        for (int j = 0; j < 4; ++j) { const int s = 2 * j + par;
            attn_unit(bh >> 4, bh & 15, 15 - s, Q, K, V, O, lds);
            attn_unit(bh >> 4, bh & 15, s, Q, K, V, O, lds); }
    }
}
}
namespace lru {
#define LR_LAS __attribute__((address_space(3)))
typedef unsigned short bf16_t;
typedef short bf16x8 __attribute__((ext_vector_type(8)));
typedef float f32x16 __attribute__((ext_vector_type(16)));
typedef float f32x4 __attribute__((ext_vector_type(4)));
typedef unsigned u32x4 __attribute__((ext_vector_type(4)));
constexpr int SEQ = 4096, DM = 1024, AP = 528, A_OFF = 0, B_OFF = 128 * AP, U_OFF = B_OFF + 64 * AP, HP = 36, W_OFF = U_OFF + 128 * HP * 4, LDS_END = W_OFF + 1024;
static_assert(LDS_END <= 131072, "lru phase LDS");
__device__ __forceinline__ float lo16(unsigned w) { return __uint_as_float(w << 16); }
__device__ __forceinline__ float hi16(unsigned w) { return __uint_as_float(w & 0xffff0000u); }
__device__ __forceinline__ unsigned cvtpk(float lo, float hi) { unsigned r; asm volatile("v_cvt_pk_bf16_f32 %0, %1, %2" : "=v"(r) : "v"(lo), "v"(hi)); return r; }
__device__ __forceinline__ float sigm(float x) { return __builtin_amdgcn_rcpf(1.0f + __builtin_amdgcn_exp2f(-1.4426950408889634f * x)); }
__device__ __forceinline__ float fmac(float a, float b, float c) { asm("v_fmac_f32 %0, %1, %2" : "+v"(c) : "v"(a), "v"(b)); return c; }
#define LR_SWAP(x, L, H) do { const auto rr_ = __builtin_amdgcn_permlane32_swap(__float_as_uint(x), __float_as_uint(x), false, false); L = __uint_as_float(rr_[0]); H = __uint_as_float(rr_[1]); } while (0)

__device__ __forceinline__ void lru_phase(int vcu, int G, const bf16_t* REC  , int Mtot, const bf16_t* RP_unused, const bf16_t* GB, bf16_t* Y, const bf16_t* GwT, const float* conv_w, const float* conv_b, const float* gate_b, const float* CN2,
                                          LR_LAS unsigned char* lds) {
    const int tid = threadIdx.x, lane = tid & 63, r32 = lane & 31, hi = lane >> 5; const int wid = __builtin_amdgcn_readfirstlane(tid >> 6);
    const int role = wid >> 2, tg = wid & 3;
    LR_LAS float* U = (LR_LAS float*)(lds + U_OFF); LR_LAS float* Hs = U; LR_LAS float* WAGG = (LR_LAS float*)(lds + W_OFF);
    for (int it = vcu; it < 256; it += G) {
        const int s = it & 7, blk = (it >> 3) & 3, b = it >> 5;
        const int chb = blk * 256, ch0 = chb + s * 32;
        const size_t rowb = (size_t)b * SEQ;
        __syncthreads();
        {
            const int n = tid >> 3, q = tid & 7, g = n >> 5, c = n & 31, d = s * 32 + c;
            const bf16_t* src = GwT + ((size_t)((blk * 2 + (d >> 7)) * 256 + g * 128 + (d & 127))) * 256 + q * 32;
#pragma unroll
            for (int j = 0; j < 4; ++j) *(LR_LAS u32x4*)(lds + B_OFF + n * AP + q * 64 + j * 16) = *(const u32x4*)(src + j * 8);
        }
        const int cc = tid & 31, tg8 = tid >> 5, cch = chb + cc * 8;
        const float gbias = gate_b[role * 1024 + ch0 + r32], cn2 = CN2[ch0 + r32];
        float carry = 0.0f;
        const bool all_small = __builtin_amdgcn_ballot_w64(!(cn2 * 1.3862943611198906f > -0.35f)) == 0ull;
        const bf16_t* recb = REC + ((size_t)blk * Mtot + rowb) * 256 + cc * 8;
        u32x4 win[8];
#pragma unroll
        for (int i = 0; i < 8; ++i) win[i] = *(const u32x4*)(recb + (size_t)(8 * tg8 + i) * 256);
        for (int tile = 0; tile < SEQ / 128; ++tile) {
            const int t0 = tile * 128;
#pragma unroll
            for (int j = 0; j < 8; ++j) *(LR_LAS u32x4*)(lds + A_OFF + (8 * tg8 + j) * AP + cc * 16) = win[j];
            __syncthreads();
            if (tile + 1 < SEQ / 128) {
#pragma unroll
                for (int i = 0; i < 8; ++i) win[i] = *(const u32x4*)(recb + (size_t)(t0 + 128 + 8 * tg8 + i) * 256); }
            const u32x4 gbv = *(const u32x4*)(GB + (rowb + t0 + (tid >> 2)) * DM + ch0 + (tid & 3) * 8);
            f32x16 acc = {};
            { const LR_LAS unsigned char* ap = lds + A_OFF + (32 * tg + r32) * AP + hi * 16; const LR_LAS unsigned char* bp = lds + B_OFF + (role * 32 + r32) * AP + hi * 16;
#pragma unroll
              for (int ks = 0; ks < 16; ++ks) acc = __builtin_amdgcn_mfma_f32_32x32x16_bf16(*(const LR_LAS bf16x8*)(ap + ks * 32), *(const LR_LAS bf16x8*)(bp + ks * 32), acc, 0, 0, 0); }
            float av[16], bv[16];
            if (role) {
#pragma unroll
                for (int r = 0; r < 16; ++r) { const int tl = 32 * tg + (r & 3) + 8 * (r >> 2) + 4 * hi;
                    const float rec = __uint_as_float((unsigned)(*(const LR_LAS unsigned short*)(lds + A_OFF + tl * AP + (s * 32 + r32) * 2)) << 16);
                    U[(tg * 16 + r) * 64 + lane] = sigm(acc[r] + gbias) * rec; }
            } else {
#pragma unroll
                for (int r = 0; r < 16; ++r) { const float la2 = cn2 * sigm(acc[r] + gbias);
                    av[r] = __builtin_amdgcn_exp2f(la2);
                    const float x = la2 * 1.3862943611198906f;
                    const float pm2 = -x * (1.0f + x * 0.5f * (1.0f + x * (1.0f / 3.0f) * (1.0f + x * 0.25f * (1.0f + x * 0.2f * (1.0f + x * (1.0f / 6.0f))))));
                    bv[r] = pm2; }
                if (!all_small) {
#pragma unroll
                    for (int r = 0; r < 16; ++r) if (__builtin_amdgcn_logf(av[r]) * 1.3862943611198906f <= -0.35f) bv[r] = fmaxf(1.0f - av[r] * av[r], 0.0f); }
#pragma unroll
                for (int r = 0; r < 16; ++r) bv[r] = __builtin_amdgcn_sqrtf(bv[r]);
            }
            __syncthreads();
            float PA[4], PB[4];
            if (!role) {
#pragma unroll
                for (int r = 0; r < 16; ++r) bv[r] *= U[(tg * 16 + r) * 64 + lane];
                float XA = 1.0f, XB = 0.0f;
#pragma unroll
                for (int i = 0; i < 4; ++i) {
                    float Ag = av[4 * i], Bg = bv[4 * i];
#pragma unroll
                    for (int k = 1; k < 4; ++k) { Bg = av[4 * i + k] * Bg + bv[4 * i + k]; Ag *= av[4 * i + k]; }
                    float AL, AH, BL, BH; LR_SWAP(Ag, AL, AH); LR_SWAP(Bg, BL, BH);
                    const float tA = XA * AL, tB = AL * XB + BL;
                    PA[i] = hi ? tA : XA; PB[i] = hi ? tB : XB;
                    XA = tA * AH; XB = AH * tB + BH; }
                if (hi == 0) { WAGG[(tg * 2) * 32 + r32] = XA; WAGG[(tg * 2 + 1) * 32 + r32] = XB; }
            }
            __syncthreads();
            if (!role) {
                float hin = carry;
#pragma unroll
                for (int t4 = 0; t4 < 4; ++t4) { const float wa = WAGG[(t4 * 2) * 32 + r32], wb = WAGG[(t4 * 2 + 1) * 32 + r32]; if (t4 < tg) hin = wa * hin + wb; carry = wa * carry + wb; }
#pragma unroll
                for (int i = 0; i < 4; ++i) { float h = PA[i] * hin + PB[i];
#pragma unroll
                    for (int k = 0; k < 4; ++k) { h = av[4 * i + k] * h + bv[4 * i + k]; Hs[(32 * tg + k + 8 * i + 4 * hi) * HP + r32] = h; } }
            }
            __syncthreads();
            { const LR_LAS float* hp = Hs + (tid >> 2) * HP + (tid & 3) * 8; const f32x4 h0 = *(const LR_LAS f32x4*)hp, h1 = *(const LR_LAS f32x4*)(hp + 4);
              u32x4 y; y.x = cvtpk(lo16(gbv.x) * h0.x, hi16(gbv.x) * h0.y); y.y = cvtpk(lo16(gbv.y) * h0.z, hi16(gbv.y) * h0.w); y.z = cvtpk(lo16(gbv.z) * h1.x, hi16(gbv.z) * h1.y); y.w = cvtpk(lo16(gbv.w) * h1.z, hi16(gbv.w) * h1.w);
              *(u32x4*)(Y + (rowb + t0 + (tid >> 2)) * DM + ch0 + (tid & 3) * 8) = y; }
        }
    }
}
}
#ifndef DUP_MASK
#define DUP_MASK 0u
#endif
#ifndef SYNC_REPS
#define SYNC_REPS 1
#endif
#define GSYNC() do { for (int s_ = 0; s_ < SYNC_REPS; ++s_) xcd_barrier(bar); } while (0)
constexpr int NWAVES = 8, NTHREADS = 512;
constexpr int BATCH = 8, SEQ = 4096, D = 1024, M = BATCH * SEQ, FF = 2816, NFF2 = 2 * FF, NLRU2 = 2048, NQKV = 3072;
constexpr size_t MiB = 1u << 20;
constexpr size_t WS_WIN = 1 * MiB, WS_GW = 5 * MiB, WS_WOUT = 6 * MiB, WS_WQKV = 8 * MiB, WS_WO = 14 * MiB, WS_W1 = 16 * MiB  , WS_W2 = 38 * MiB  ;
constexpr size_t WS_CN = 49 * MiB;
constexpr size_t WS_SS = 50 * MiB  , WS_AGG = 58 * MiB  ;
constexpr size_t WS_XN0 = 64 * MiB, WS_RP = 128 * MiB, WS_A = 64 * MiB  , WS_GB = 192 * MiB, WS_REC = 256 * MiB, WS_B = 320 * MiB  ;
constexpr size_t WS_Y = 256 * MiB, WS_H = 64 * MiB  , WS_HB = 192 * MiB, WS_HID = 256 * MiB  ;
constexpr size_t WS_Q = 256 * MiB, WS_K = 320 * MiB, WS_V = 384 * MiB, WS_O = 448 * MiB, WS_END = 512 * MiB;
constexpr int MISC_OFF = 131072 + 320;
constexpr size_t WS_CTL = 0;
constexpr int LDS_BYTES = 147456;

#define LAS __attribute__((address_space(3)))
#define GAS __attribute__((address_space(1)))
typedef GAS unsigned gu32;
typedef GAS unsigned long long gu64;
#define RLX_AGENT __ATOMIC_RELAXED, __HIP_MEMORY_SCOPE_AGENT
#define LDS_WAIT() asm volatile("s_waitcnt lgkmcnt(0)" ::: "memory")
#define VM_WAIT() asm volatile("s_waitcnt vmcnt(0)" ::: "memory")
__device__ __forceinline__ unsigned long long rt() { return __builtin_amdgcn_s_memrealtime(); }

#define XB_TMO      128
#define XB_XCNT(j)  (256  + 64 * (j))
#define XB_XSUB(j)  (1280 + 64 * (j))
#define XB_XGEN(j)  (2304 + 64 * (j))
#define XB_TOP      3328
#define XB_TOPGEN   3392
#define XCD_BAR_WORDS 3456
#define XB_SPIN_CAP (1u << 18)

__device__ __forceinline__ unsigned xb_ld(unsigned* p)              { return __hip_atomic_load(p, __ATOMIC_RELAXED, __HIP_MEMORY_SCOPE_AGENT); }
__device__ __forceinline__ unsigned xb_add(unsigned* p, unsigned v) { return __hip_atomic_fetch_add(p, v, __ATOMIC_RELAXED, __HIP_MEMORY_SCOPE_AGENT); }
__device__ __forceinline__ unsigned xb_xcc_id() { return (unsigned)__builtin_amdgcn_s_getreg((3 << 11) | 20) & 0xFu; }
#define XB_SPIN(cond, bar) do { unsigned _sp = 0; while (cond) { __builtin_amdgcn_s_sleep(1); \
    if ((++_sp & 255u) == 0u) { if (xb_ld(&(bar)[XB_TMO])) break; if (_sp > XB_SPIN_CAP) { atomicAdd(&(bar)[XB_TMO], 1u); break; } } } } while (0)

struct XcdBarrier {
    unsigned* bar; unsigned x;
    volatile LAS unsigned* st;
};

__device__ __forceinline__ XcdBarrier xcd_barrier_post(unsigned* bar, volatile LAS unsigned* st) {
    XcdBarrier b; b.bar = bar; b.x = xb_xcc_id(); b.st = st;
    if (threadIdx.x == 0) (void)xb_add(&bar[XB_XCNT(b.x)], 1u);
    return b;
}
__device__ __forceinline__ void xcd_barrier_complete(unsigned* bar, unsigned x, unsigned& nloc, unsigned& nx) {
    const unsigned G = gridDim.x * gridDim.y * gridDim.z;
    unsigned sum, cnt, mine, sp = 0u;
    for (;;) {
        sum = 0u; cnt = 0u; mine = 0u;
#pragma unroll
        for (unsigned j = 0; j < 16; ++j) { const unsigned c = xb_ld(&bar[XB_XCNT(j)]); sum += c; cnt += (c > 0u) ? 1u : 0u; mine = (j == x) ? c : mine; }
        if (sum == G) break;
        __builtin_amdgcn_s_sleep(1);
        if ((++sp & 255u) == 0u) { if (xb_ld(&bar[XB_TMO])) break; if (sp > XB_SPIN_CAP) { atomicAdd(&bar[XB_TMO], 1u); break; } }
    }
    nloc = mine > 0u ? mine : 1u; nx = cnt > 0u ? cnt : 1u;
}

__device__ __forceinline__ void xcd_barrier(const XcdBarrier& b) {
    asm volatile("s_waitcnt vmcnt(0)" ::: "memory");
    __syncthreads();
    if (threadIdx.x == 0) {
        unsigned* bar = b.bar;
        __builtin_amdgcn_s_waitcnt(0);
        unsigned nloc = b.st[0], nx = b.st[1];
        if (nloc == 0u) { xcd_barrier_complete(bar, b.x, nloc, nx); b.st[0] = nloc; b.st[1] = nx; }
        const unsigned old = xb_add(&bar[XB_XSUB(b.x)], 1u);
        const unsigned gen = old / nloc;
        if (old + 1u == (gen + 1u) * nloc) {
            __builtin_amdgcn_fence(__ATOMIC_RELEASE, "agent");
            asm volatile("s_waitcnt vmcnt(0)" ::: "memory");
            const unsigned og = xb_add(&bar[XB_TOP], 1u);
            const unsigned tg = og / nx;
            if (og + 1u == (tg + 1u) * nx) xb_add(&bar[XB_TOPGEN], 1u);
            else XB_SPIN(xb_ld(&bar[XB_TOPGEN]) == tg, bar);
            __builtin_amdgcn_fence(__ATOMIC_ACQUIRE, "agent");
            xb_add(&bar[XB_XGEN(b.x)], 1u);
            asm volatile("s_waitcnt vmcnt(0)" ::: "memory");
        } else {
            XB_SPIN(xb_ld(&bar[XB_XGEN(b.x)]) == gen, bar);
            __builtin_amdgcn_fence(__ATOMIC_ACQUIRE, "agent");
            asm volatile("s_waitcnt vmcnt(0)" ::: "memory");
        }
    }
    __syncthreads();
}

typedef unsigned short bf16;
typedef unsigned v4u __attribute__((ext_vector_type(4)));
typedef unsigned v2u __attribute__((ext_vector_type(2)));
typedef float f32x4 __attribute__((ext_vector_type(4)));
__device__ __forceinline__ unsigned f2bf(float f) { unsigned u = __builtin_bit_cast(unsigned, f); return (u + 0x7fffu + ((u >> 16) & 1u)) >> 16; }
__device__ __forceinline__ unsigned pk2(float lo, float hi) { return f2bf(lo) | (f2bf(hi) << 16); }
__device__ __forceinline__ float bflo(unsigned w) { return __uint_as_float(w << 16); }
__device__ __forceinline__ float bfhi(unsigned w) { return __uint_as_float(w & 0xffff0000u); }
__device__ __forceinline__ float wave_sum(float v) {
#pragma unroll
    for (int o = 1; o < 64; o <<= 1) v += __shfl_xor(v, o);
    return v;
}

struct Params {
    const float *x, *mix_norm, *ffn_norm, *final_norm, *lru_w_in, *lru_b_in, *lru_conv_w, *lru_conv_b, *lru_gate_w, *lru_gate_b, *lru_lambda, *lru_w_out, *lru_b_out,
                *attn_w_qkv, *attn_w_o, *ffn_w_in, *ffn_w_out;
    float* out; unsigned char* ws;
};

__device__ __forceinline__ void transpose_item(const float* W, int K, int N, bf16* WT, const float* gain, int mode, int base, int split, LAS float* scr, int item, int lane) {
    const int nblk = N / 64, kb = item / nblk, nb = item % nblk, k0 = 32 * kb, n0 = 64 * nb;
    const int lr = lane >> 4, lc = (lane & 15) * 4;
    f32x4 v[8];
#pragma unroll
    for (int i = 0; i < 8; ++i) v[i] = *(const f32x4*)(W + (size_t)(k0 + 4 * i + lr) * N + n0 + lc);
#pragma unroll
    for (int i = 0; i < 8; ++i) { const int kk = 4 * i + lr; const float g = gain ? gain[k0 + kk] : 1.0f; LAS float* d = scr + kk * 65 + lc; d[0] = v[i].x * g; d[1] = v[i].y * g; d[2] = v[i].z * g; d[3] = v[i].w * g; }
    asm volatile("s_waitcnt lgkmcnt(0)" ::: "memory");
    const int c = lane & 3;
#pragma unroll
    for (int j = 0; j < 4; ++j) { const int nl = (lane >> 2) + 16 * j; const int n = n0 + nl; const LAS float* s = scr + (8 * c) * 65 + nl;
        int dr; if (mode == 0) dr = base + n; else { const int hi_ = n >= split; const int nn = hi_ ? n - split : n; dr = base + (hi_ ? 128 : 0) + (nn >> 7) * 256 + (nn & 127); }
        v4u o; o.x = pk2(s[0 * 65], s[1 * 65]); o.y = pk2(s[2 * 65], s[3 * 65]); o.z = pk2(s[4 * 65], s[5 * 65]); o.w = pk2(s[6 * 65], s[7 * 65]);
        *(v4u*)(WT + (size_t)dr * K + k0 + 8 * c) = o; }
    asm volatile("s_waitcnt lgkmcnt(0)" ::: "memory");
}

__device__ __forceinline__ void rms_row_to_bf16(const float* xrow, const float* g, bf16* orow, int lane) {
    const f32x4* xr = (const f32x4*)xrow + lane; const f32x4* gr = (const f32x4*)g + lane;
    f32x4 v[4]; float s = 0.f;
#pragma unroll
    for (int j = 0; j < 4; ++j) { v[j] = xr[64 * j]; s += (v[j].x * v[j].x + v[j].y * v[j].y) + (v[j].z * v[j].z + v[j].w * v[j].w); }
    const float rstd = 1.0f / sqrtf(wave_sum(s) * (1.f / D) + 1e-6f);
    unsigned long long* o8 = (unsigned long long*)orow + lane;
#pragma unroll
    for (int j = 0; j < 4; ++j) { const f32x4 gg = gr[64 * j]; o8[64 * j] = (unsigned long long)pk2(v[j].x * rstd * gg.x, v[j].y * rstd * gg.y) | ((unsigned long long)pk2(v[j].z * rstd * gg.z, v[j].w * rstd * gg.w) << 32); }
}
__device__ __forceinline__ void rms_row2_to_bf16(const float* xrow, const float* g, bf16* orow, int lane) {
    const f32x4* xr = (const f32x4*)xrow + lane; const f32x4* gr = (const f32x4*)g + lane;
    f32x4 v[8], gv[4]; float s0 = 0.f, s1 = 0.f;
#pragma unroll
    for (int j = 0; j < 8; ++j) v[j] = xr[64 * j];
#pragma unroll
    for (int j = 0; j < 4; ++j) gv[j] = gr[64 * j];
#pragma unroll
    for (int j = 0; j < 4; ++j) { s0 += (v[j].x * v[j].x + v[j].y * v[j].y) + (v[j].z * v[j].z + v[j].w * v[j].w); s1 += (v[4 + j].x * v[4 + j].x + v[4 + j].y * v[4 + j].y) + (v[4 + j].z * v[4 + j].z + v[4 + j].w * v[4 + j].w); }
    const float r0 = 1.0f / sqrtf(wave_sum(s0) * (1.f / D) + 1e-6f), r1 = 1.0f / sqrtf(wave_sum(s1) * (1.f / D) + 1e-6f);
    unsigned long long* o8 = (unsigned long long*)orow + lane;
#pragma unroll
    for (int j = 0; j < 4; ++j) { const f32x4 gg = gv[j];
        o8[64 * j] = (unsigned long long)pk2(v[j].x * r0 * gg.x, v[j].y * r0 * gg.y) | ((unsigned long long)pk2(v[j].z * r0 * gg.z, v[j].w * r0 * gg.w) << 32);
        o8[256 + 64 * j] = (unsigned long long)pk2(v[4 + j].x * r1 * gg.x, v[4 + j].y * r1 * gg.y) | ((unsigned long long)pk2(v[4 + j].z * r1 * gg.z, v[4 + j].w * r1 * gg.w) << 32); }
}
__device__ __forceinline__ void final_row(const bf16* hrow, const float* ss16, const float* g, float* orow, int lane) {
    const f32x4* sp = (const f32x4*)ss16; const f32x4 a = sp[0], b = sp[1], c = sp[2], d = sp[3];
    const float s = ((a.x + a.y) + (a.z + a.w)) + ((b.x + b.y) + (b.z + b.w)) + ((c.x + c.y) + (c.z + c.w)) + ((d.x + d.y) + (d.z + d.w));
    const float rstd = 1.0f / sqrtf(s * (1.f / D) + 1e-6f);
#pragma unroll
    for (int j = 0; j < 2; ++j) { const v4u w = *((const v4u*)hrow + lane + 64 * j); const f32x4 g0 = *((const f32x4*)g + 2 * lane + 128 * j), g1 = *((const f32x4*)g + 2 * lane + 128 * j + 1);
        f32x4* o = (f32x4*)orow + 2 * lane + 128 * j;
        o[0] = (f32x4){bflo(w.x) * rstd * g0.x, bfhi(w.x) * rstd * g0.y, bflo(w.y) * rstd * g0.z, bfhi(w.y) * rstd * g0.w};
        o[1] = (f32x4){bflo(w.z) * rstd * g1.x, bfhi(w.z) * rstd * g1.y, bflo(w.w) * rstd * g1.z, bfhi(w.w) * rstd * g1.w}; }
}

__global__ void __launch_bounds__(NTHREADS, 2) hybrid_fwd(Params p) {
    extern __shared__ __attribute__((aligned(16))) unsigned char lds_raw[];
    LAS unsigned char* lds = (LAS unsigned char*)lds_raw;
    cg::grid_group grid = cg::this_grid();
    volatile LAS unsigned* MISC = (volatile LAS unsigned*)(lds + MISC_OFF);
    if (threadIdx.x < 32) MISC[threadIdx.x] = 0u;
    __syncthreads();
    const int tid = threadIdx.x, lane = tid & 63, wave = __builtin_amdgcn_readfirstlane(tid >> 6);
    const int G = gridDim.x, bx = blockIdx.x; const int vcu = (G % 8 == 0) ? (bx % 8) * (G / 8) + bx / 8 : bx;
    const int gw = vcu * NWAVES + wave, NGW = G * NWAVES; const int gt = vcu * NTHREADS + tid, NGT = G * NTHREADS;
    unsigned char* ws = p.ws;
    bf16 *WinT = (bf16*)(ws + WS_WIN), *GwT = (bf16*)(ws + WS_GW), *WoutT = (bf16*)(ws + WS_WOUT), *WqkvT = (bf16*)(ws + WS_WQKV), *WoT = (bf16*)(ws + WS_WO), *W1T = (bf16*)(ws + WS_W1), *W2T = (bf16*)(ws + WS_W2);
    float* SS = (float*)(ws + WS_SS); float* AGGA = (float*)(ws + WS_AGG); float* AGGB = AGGA + (size_t)BATCH * 64 * D;
    bf16 *XN0 = (bf16*)(ws + WS_XN0), *RP = (bf16*)(ws + WS_RP), *GB = (bf16*)(ws + WS_GB), *REC = (bf16*)(ws + WS_REC), *Y = (bf16*)(ws + WS_Y), *HB = (bf16*)(ws + WS_HB), *HID = (bf16*)(ws + WS_HID);
    bf16 *Qb = (bf16*)(ws + WS_Q), *Kb = (bf16*)(ws + WS_K), *Vb = (bf16*)(ws + WS_V), *Ob = (bf16*)(ws + WS_O);
    float* CN = (float*)(ws + WS_CN);
    unsigned* AB = (unsigned*)(ws + WS_B);
    constexpr size_t SS_STRIDE = (size_t)M * 16;

    for (int rep_ = 0; rep_ < 1 + ((DUP_MASK >> 0) & 1); ++rep_) {
        LAS float* scr = (LAS float*)(lds + wave * 16384);
        constexpr int I_WIN = (D / 32) * (NLRU2 / 64), I_G1 = (256 / 32) * (256 / 64), I_G = 8 * I_G1, I_SQ = (D / 32) * (D / 64), I_QKV = (D / 32) * (NQKV / 64), I_W1 = (D / 32) * (NFF2 / 64), I_W2 = (FF / 32) * (D / 64);
        constexpr int NITEMS = I_WIN + I_G + I_SQ + I_QKV + I_SQ + 2 * I_W1 + 2 * I_W2;
        for (int it = gw; it < NITEMS; it += NGW) {
            int r = it;
            if (r < I_WIN) { transpose_item(p.lru_w_in, D, NLRU2, WinT, nullptr, 0, 0, 0, scr, r, lane); continue; } r -= I_WIN;
            if (r < I_G) { const int mi = r / I_G1, g = mi >> 2, blk = mi & 3;
                transpose_item(p.lru_gate_w + (size_t)mi * 65536, 256, 256, GwT, nullptr, 1, blk * 512 + g * 128, 1 << 30, scr, r % I_G1, lane); continue; } r -= I_G;
            if (r < I_SQ) { transpose_item(p.lru_w_out, D, D, WoutT, nullptr, 0, 0, 0, scr, r, lane); continue; } r -= I_SQ;
            if (r < I_QKV) { transpose_item(p.attn_w_qkv, D, NQKV, WqkvT, p.mix_norm + D, 0, 0, 0, scr, r, lane); continue; } r -= I_QKV;
            if (r < I_SQ) { transpose_item(p.attn_w_o, D, D, WoT, nullptr, 0, 0, 0, scr, r, lane); continue; } r -= I_SQ;
            if (r < 2 * I_W1) { const int l = r / I_W1; transpose_item(p.ffn_w_in + (size_t)l * D * NFF2, D, NFF2, W1T + (size_t)l * NFF2 * D, p.ffn_norm + l * D, 1, 0, FF, scr, r % I_W1, lane); continue; } r -= 2 * I_W1;
            { const int l = r / I_W2; transpose_item(p.ffn_w_out + (size_t)l * FF * D, FF, D, W2T + (size_t)l * D * FF, nullptr, 0, 0, 0, scr, r % I_W2, lane); }
        }
        for (int m = 2 * gw; m < M; m += 2 * NGW) rms_row2_to_bf16(p.x + (size_t)m * D, p.mix_norm, XN0 + (size_t)m * D, lane);
        if (gt < D) CN[gt] = -8.0f * 1.4426950408889634f * log1pf(expf(-p.lru_lambda[gt]));
        if (bx == 0) for (int i = tid; i < XCD_BAR_WORDS; i += NTHREADS) ((unsigned*)(ws + WS_CTL))[i] = 0u;
    }
    grid.sync();
    const XcdBarrier bar = xcd_barrier_post((unsigned*)(ws + WS_CTL), MISC + 8);

    for (int rep_ = 0; rep_ < 1 + ((DUP_MASK >> 1) & 1); ++rep_) {
        pg8::Gemm g{XN0, WinT, M, NLRU2, D}; pg8::StaticOrder S; S.init(M, NLRU2, G, bx);
        pg8::EpiLruIn E{GB, RP, p.lru_b_in};
        pg8::gemm_phase<pg8::EpiLruIn, pg8::StaticOrder, true, true>(lds, g, S, E);
#ifdef P1_TWICE
        pg8::gemm_phase<pg8::EpiLruIn, pg8::StaticOrder, true, true>(lds, g, S, E);
#endif
    }
    GSYNC();

#ifndef UNFUSED_LRU
    bf16* RECX = (bf16*)(ws + WS_XN0);
    {
        static_assert(NTHREADS % 128 == 0, "a thread keeps its channel chunk across items");
        const int cc = gt & 127, ch = cc * 8;
        float wk[4][8], bia[8];
#pragma unroll
        for (int k = 0; k < 4; ++k) { const f32x4 a = *(const f32x4*)(p.lru_conv_w + k * D + ch), b = *(const f32x4*)(p.lru_conv_w + k * D + ch + 4);
            wk[k][0] = a.x; wk[k][1] = a.y; wk[k][2] = a.z; wk[k][3] = a.w; wk[k][4] = b.x; wk[k][5] = b.y; wk[k][6] = b.z; wk[k][7] = b.w; }
        { const f32x4 a = *(const f32x4*)(p.lru_conv_b + ch), b = *(const f32x4*)(p.lru_conv_b + ch + 4); bia[0] = a.x; bia[1] = a.y; bia[2] = a.z; bia[3] = a.w; bia[4] = b.x; bia[5] = b.y; bia[6] = b.z; bia[7] = b.w; }
        const int NIT = (M / 8) * 128;
        auto load_win = [&](int it, v4u (&win)[11]) { const int row0 = (it >> 7) * 8, t0 = row0 & (SEQ - 1);
#pragma unroll
            for (int i = 0; i < 11; ++i) { const int t = t0 - 3 + i; win[i] = (t >= 0) ? *(const v4u*)(RP + (size_t)(row0 - 3 + i) * D + ch) : (v4u){0u, 0u, 0u, 0u}; } };
        auto conv_store = [&](int it, const v4u (&win)[11]) { const int row0 = (it >> 7) * 8;
            bf16* dst = RECX + ((size_t)(cc >> 5) * M + row0) * 256 + (cc & 31) * 8;
#pragma unroll
            for (int j = 0; j < 8; ++j) {
                float acc[8];
#pragma unroll
                for (int e = 0; e < 8; ++e) acc[e] = bia[e];
#pragma unroll
                for (int k = 0; k < 4; ++k) { const v4u x = win[j + k];
                    acc[0] = lru::fmac(wk[k][0], bflo(x.x), acc[0]); acc[1] = lru::fmac(wk[k][1], bfhi(x.x), acc[1]); acc[2] = lru::fmac(wk[k][2], bflo(x.y), acc[2]); acc[3] = lru::fmac(wk[k][3], bfhi(x.y), acc[3]);
                    acc[4] = lru::fmac(wk[k][4], bflo(x.z), acc[4]); acc[5] = lru::fmac(wk[k][5], bfhi(x.z), acc[5]); acc[6] = lru::fmac(wk[k][6], bflo(x.w), acc[6]); acc[7] = lru::fmac(wk[k][7], bfhi(x.w), acc[7]); }
                v4u o; o.x = pk2(acc[0], acc[1]); o.y = pk2(acc[2], acc[3]); o.z = pk2(acc[4], acc[5]); o.w = pk2(acc[6], acc[7]);
                *(v4u*)(dst + (size_t)j * 256) = o; } };
        v4u wa[11], wb[11];
        if (gt < NIT) load_win(gt, wa);
        for (int it = gt; it < NIT; it += 2 * NGT) {
            if (it + NGT < NIT) load_win(it + NGT, wb);
            conv_store(it, wa);
            if (it + 2 * NGT < NIT) load_win(it + 2 * NGT, wa);
            if (it + NGT < NIT) conv_store(it + NGT, wb);
        }
    }
    GSYNC();

    lru::lru_phase(vcu, G, RECX, M, RP, GB, Y, GwT, p.lru_conv_w, p.lru_conv_b, p.lru_gate_b, CN, lds);
#ifdef LRU_TWICE
    lru::lru_phase(vcu, G, RP, GB, Y, GwT, p.lru_conv_w, p.lru_conv_b, p.lru_gate_b, CN, lds);
#endif
    GSYNC();
#else
    for (int rep_ = 0; rep_ < 1 + ((DUP_MASK >> 2) & 1); ++rep_) {
        for (int it = gt; it < (M / 8) * 128; it += NGT) {
            const int cc = it & 127, tg = it >> 7; const int row0 = tg * 8, t0 = row0 & (SEQ - 1), ch = cc * 8;
            float wk[4][8], bia[8];
#pragma unroll
            for (int k = 0; k < 4; ++k) { const f32x4 a = *(const f32x4*)(p.lru_conv_w + k * D + ch), b = *(const f32x4*)(p.lru_conv_w + k * D + ch + 4);
                wk[k][0] = a.x; wk[k][1] = a.y; wk[k][2] = a.z; wk[k][3] = a.w; wk[k][4] = b.x; wk[k][5] = b.y; wk[k][6] = b.z; wk[k][7] = b.w; }
            { const f32x4 a = *(const f32x4*)(p.lru_conv_b + ch), b = *(const f32x4*)(p.lru_conv_b + ch + 4); bia[0] = a.x; bia[1] = a.y; bia[2] = a.z; bia[3] = a.w; bia[4] = b.x; bia[5] = b.y; bia[6] = b.z; bia[7] = b.w; }
            v4u win[11];
#pragma unroll
            for (int i = 0; i < 11; ++i) { const int t = t0 - 3 + i; win[i] = (t >= 0) ? *(const v4u*)(RP + (size_t)(row0 - 3 + i) * D + ch) : (v4u){0u, 0u, 0u, 0u}; }
            bf16* dst = REC + ((size_t)(cc >> 5) * M + row0) * 256 + (cc & 31) * 8;
#pragma unroll
            for (int j = 0; j < 8; ++j) {
                float acc[8];
#pragma unroll
                for (int e = 0; e < 8; ++e) acc[e] = bia[e];
#pragma unroll
                for (int k = 0; k < 4; ++k) { const v4u x = win[j + k];
                    acc[0] += wk[k][0] * bflo(x.x); acc[1] += wk[k][1] * bfhi(x.x); acc[2] += wk[k][2] * bflo(x.y); acc[3] += wk[k][3] * bfhi(x.y);
                    acc[4] += wk[k][4] * bflo(x.z); acc[5] += wk[k][5] * bfhi(x.z); acc[6] += wk[k][6] * bflo(x.w); acc[7] += wk[k][7] * bfhi(x.w); }
                v4u o; o.x = pk2(acc[0], acc[1]); o.y = pk2(acc[2], acc[3]); o.z = pk2(acc[4], acc[5]); o.w = pk2(acc[6], acc[7]);
                *(v4u*)(dst + (size_t)j * 256) = o; }
        }
    }
    GSYNC();

    for (int rep_ = 0; rep_ < 1 + ((DUP_MASK >> 3) & 1); ++rep_) {
        pg8::Gemm g{REC, GwT, 4 * M, 512, 256}; pg8::GateOrder S; S.base.init(4 * M, 512, G, bx);
        pg8::EpiGate E{REC, p.lru_gate_b, CN, AB, M};
        pg8::gemm_phase<pg8::EpiGate, pg8::GateOrder, true, true>(lds, g, S, E);
#ifdef GATE_TWICE
        { pg8::EpiGate E2{REC, p.lru_gate_b, CN, (unsigned*)(ws + WS_XN0), M}; pg8::gemm_phase<pg8::EpiGate, pg8::GateOrder, true, true>(lds, g, S, E2); }
#endif
    }
    GSYNC();

    for (int rep_ = 0; rep_ < 1 + ((DUP_MASK >> 4) & 1); ++rep_) {
        for (int it = vcu; it < BATCH * 32; it += G) {
            const int b = it >> 5, c = ((it & 31) << 1) + (tid >> 8), ch = (tid & 255) * 4;
            const size_t base = ((size_t)b * SEQ + (size_t)c * 64) * D + ch;
            f32x4 Ap = {1.f, 1.f, 1.f, 1.f}, Hh = {0.f, 0.f, 0.f, 0.f};
#pragma unroll 8
            for (int t = 0; t < 64; ++t) { const v4u w = *(const v4u*)(AB + base + (size_t)t * D);
                const f32x4 a = {__builtin_amdgcn_exp2f(bflo(w.x)), __builtin_amdgcn_exp2f(bflo(w.y)), __builtin_amdgcn_exp2f(bflo(w.z)), __builtin_amdgcn_exp2f(bflo(w.w))};
                const f32x4 bb = {bfhi(w.x), bfhi(w.y), bfhi(w.z), bfhi(w.w)}; Hh = a * Hh + bb; Ap = Ap * a; }
            const size_t ao = ((size_t)b * 64 + c) * D + ch; *(f32x4*)(AGGA + ao) = Ap; *(f32x4*)(AGGB + ao) = Hh;
        }
    }
    GSYNC();
    for (int rep_ = 0; rep_ < 1 + ((DUP_MASK >> 5) & 1); ++rep_) {
        for (int it = vcu; it < BATCH * 32; it += G) {
            const int b = it >> 5, c = ((it & 31) << 1) + (tid >> 8), ch = (tid & 255) * 4;
            f32x4 Hh = {0.f, 0.f, 0.f, 0.f};
            for (int cc = 0; cc < c; ++cc) { const size_t ao = ((size_t)b * 64 + cc) * D + ch; Hh = *(const f32x4*)(AGGA + ao) * Hh + *(const f32x4*)(AGGB + ao); }
            const size_t base = ((size_t)b * SEQ + (size_t)c * 64) * D + ch;
#pragma unroll 8
            for (int t = 0; t < 64; ++t) { const size_t o = base + (size_t)t * D; const v4u w = *(const v4u*)(AB + o);
                const f32x4 a = {__builtin_amdgcn_exp2f(bflo(w.x)), __builtin_amdgcn_exp2f(bflo(w.y)), __builtin_amdgcn_exp2f(bflo(w.z)), __builtin_amdgcn_exp2f(bflo(w.w))};
                const f32x4 bb = {bfhi(w.x), bfhi(w.y), bfhi(w.z), bfhi(w.w)}; Hh = a * Hh + bb;
                const v2u g = *(const v2u*)(GB + o); v2u y; y.x = pk2(bflo(g.x) * Hh.x, bfhi(g.x) * Hh.y); y.y = pk2(bflo(g.y) * Hh.z, bfhi(g.y) * Hh.w); *(v2u*)(Y + o) = y; }
        }
    }
    GSYNC();

#endif
    for (int rep_ = 0; rep_ < 1 + ((DUP_MASK >> 6) & 1); ++rep_) {
        pg8::Gemm g{Y, WoutT, M, D, D}; pg8::StaticOrder S; S.init(M, D, G, bx);
        pg8::EpiResid<false, false, true> E{p.x, nullptr, HB, SS, p.lru_b_out};
        pg8::gemm_phase<pg8::EpiResid<false, false, true>, pg8::StaticOrder, true, true>(lds, g, S, E);
#ifdef P5_TWICE
        pg8::gemm_phase<pg8::EpiResid<false, false>, pg8::StaticOrder, true, true>(lds, g, S, E);
#endif
    }
    GSYNC();
    for (int rep_ = 0; rep_ < 1 + ((DUP_MASK >> 7) & 1); ++rep_) {
        pg8::Gemm g{HB, W1T, M, NFF2, D}; pg8::StaticOrder S; S.init(M, NFF2, G, bx);
        pg8::EpiSwiglu E{SS, HID, FF};
        pg8::gemm_phase<pg8::EpiSwiglu, pg8::StaticOrder, true, true>(lds, g, S, E);
#ifdef P6_TWICE
        pg8::gemm_phase<pg8::EpiSwiglu, pg8::StaticOrder, true, true>(lds, g, S, E);
#endif
    }
    GSYNC();
    {
        pg8::Gemm g{HID, W2T, M, D, FF}; pg8::StaticOrder S; S.init(M, D, G, bx);
#ifdef P7_TWICE
        { pg8::EpiResid<true, false> E2{HB, nullptr, (bf16*)(ws + WS_XN0), SS + 3 * SS_STRIDE, nullptr}; pg8::gemm_phase<pg8::EpiResid<true, false>, pg8::StaticOrder, true, true>(lds, g, S, E2); }
#endif
        pg8::EpiResid<true, false> E{HB, nullptr, HB, SS + SS_STRIDE, nullptr};
        pg8::gemm_phase<pg8::EpiResid<true, false>, pg8::StaticOrder, true, true>(lds, g, S, E);
    }
    GSYNC();
    for (int rep_ = 0; rep_ < 1 + ((DUP_MASK >> 8) & 1); ++rep_) {
        pg8::Gemm g{HB, WqkvT, M, NQKV, D}; pg8::StaticOrder S; S.init(M, NQKV, G, bx);
        static_assert(WS_V - WS_K == WS_K - WS_Q, "Q|K|V equally spaced");
        pg8::EpiQKV E{SS + SS_STRIDE, Qb, (size_t)(WS_K - WS_Q) / 2, 0.125f * 1.4426950408889634f};
        pg8::gemm_phase<pg8::EpiQKV, pg8::StaticOrder, true, true>(lds, g, S, E);
#ifdef P8_TWICE
        pg8::gemm_phase<pg8::EpiQKV, pg8::StaticOrder, true, true>(lds, g, S, E);
#endif
    }
    GSYNC();
    for (int rep_ = 0; rep_ < 1 + ((DUP_MASK >> 9) & 1); ++rep_) sba::attn_phase(vcu, G, Qb, Kb, Vb, Ob, lds);
    GSYNC();
    for (int rep_ = 0; rep_ < 1 + ((DUP_MASK >> 10) & 1); ++rep_) {
        pg8::Gemm g{Ob, WoT, M, D, D}; pg8::StaticOrder S; S.init(M, D, G, bx);
        pg8::EpiResid<true, false> E{HB, nullptr, HB, SS + 2 * SS_STRIDE, nullptr};
        pg8::gemm_phase<pg8::EpiResid<true, false>, pg8::StaticOrder, true, true>(lds, g, S, E);
    }
    GSYNC();
    for (int rep_ = 0; rep_ < 1 + ((DUP_MASK >> 11) & 1); ++rep_) {
        pg8::Gemm g{HB, W1T + (size_t)NFF2 * D, M, NFF2, D}; pg8::StaticOrder S; S.init(M, NFF2, G, bx);
        pg8::EpiSwiglu E{SS + 2 * SS_STRIDE, HID, FF};
        pg8::gemm_phase<pg8::EpiSwiglu, pg8::StaticOrder, true, true>(lds, g, S, E);
    }
    GSYNC();
    {
        pg8::Gemm g{HID, W2T + (size_t)D * FF, M, D, FF}; pg8::StaticOrder S; S.init(M, D, G, bx);
        pg8::EpiResid<true, false> E{HB, nullptr, HB, SS + 3 * SS_STRIDE, nullptr};
        pg8::gemm_phase<pg8::EpiResid<true, false>, pg8::StaticOrder, true, true>(lds, g, S, E);
    }
    GSYNC();
    for (int m = 4 * gw; m < M; m += 4 * NGW) {
        v4u w[4][2]; float rstd[4];
#pragma unroll
        for (int r = 0; r < 4; ++r) { w[r][0] = *((const v4u*)(HB + (size_t)(m + r) * D) + lane); w[r][1] = *((const v4u*)(HB + (size_t)(m + r) * D) + lane + 64); }
#pragma unroll
        for (int r = 0; r < 4; ++r) { const f32x4* sp = (const f32x4*)(SS + 3 * SS_STRIDE + (size_t)(m + r) * 16); const f32x4 a = sp[0], b = sp[1], c = sp[2], d = sp[3];
            const float s = ((a.x + a.y) + (a.z + a.w)) + ((b.x + b.y) + (b.z + b.w)) + ((c.x + c.y) + (c.z + c.w)) + ((d.x + d.y) + (d.z + d.w)); rstd[r] = 1.0f / sqrtf(s * (1.f / D) + 1e-6f); }
        f32x4 gq[2][2];
#pragma unroll
        for (int j = 0; j < 2; ++j) { gq[j][0] = *((const f32x4*)p.final_norm + 2 * lane + 128 * j); gq[j][1] = *((const f32x4*)p.final_norm + 2 * lane + 128 * j + 1); }
#pragma unroll
        for (int j = 0; j < 2; ++j) { const f32x4 g0 = gq[j][0], g1 = gq[j][1];
#pragma unroll
            for (int r = 0; r < 4; ++r) { const v4u ww = w[r][j]; const float rs = rstd[r]; f32x4* o = (f32x4*)(p.out + (size_t)(m + r) * D) + 2 * lane + 128 * j;
                o[0] = (f32x4){bflo(ww.x) * rs * g0.x, bfhi(ww.x) * rs * g0.y, bflo(ww.y) * rs * g0.z, bfhi(ww.y) * rs * g0.w};
                o[1] = (f32x4){bflo(ww.z) * rs * g1.x, bfhi(ww.z) * rs * g1.y, bflo(ww.w) * rs * g1.z, bfhi(ww.w) * rs * g1.w}; } }
    }
}

extern "C" void kernel_launch(void* const* d_in, const int* in_sizes, int n_in, void* d_out, int out_size, void* d_ws, size_t ws_size, hipStream_t stream) {
    static int grid = 0;
    if (grid == 0) {
        if (n_in != 17 || in_sizes[0] != M * D || out_size != M * D || ws_size < WS_END) { fprintf(stderr, "kernel_launch: unexpected shapes (n_in %d, in0 %d, out %d, ws %zu)\n", n_in, n_in > 0 ? in_sizes[0] : -1, out_size, ws_size); grid = -1; return; }
        int dev = 0, cus = 0, per_cu = 0;
        if (hipGetDevice(&dev) != hipSuccess || hipDeviceGetAttribute(&cus, hipDeviceAttributeMultiprocessorCount, dev) != hipSuccess) { grid = -1; return; }
        if (hipFuncSetAttribute((const void*)hybrid_fwd, hipFuncAttributeMaxDynamicSharedMemorySize, LDS_BYTES) != hipSuccess) { fprintf(stderr, "kernel_launch: hipFuncSetAttribute failed\n"); grid = -1; return; }
        if (hipOccupancyMaxActiveBlocksPerMultiprocessor(&per_cu, (const void*)hybrid_fwd, NTHREADS, LDS_BYTES) != hipSuccess || per_cu < 1) { fprintf(stderr, "kernel_launch: occupancy query says %d\n", per_cu); per_cu = 1; }
        (void)hipGetLastError();
        grid = cus;
    }
    if (grid < 0) return;
    Params p{};
    p.x = (const float*)d_in[0]; p.mix_norm = (const float*)d_in[1]; p.ffn_norm = (const float*)d_in[2]; p.final_norm = (const float*)d_in[3];
    p.lru_w_in = (const float*)d_in[4]; p.lru_b_in = (const float*)d_in[5]; p.lru_conv_w = (const float*)d_in[6]; p.lru_conv_b = (const float*)d_in[7];
    p.lru_gate_w = (const float*)d_in[8]; p.lru_gate_b = (const float*)d_in[9]; p.lru_lambda = (const float*)d_in[10]; p.lru_w_out = (const float*)d_in[11]; p.lru_b_out = (const float*)d_in[12];
    p.attn_w_qkv = (const float*)d_in[13]; p.attn_w_o = (const float*)d_in[14]; p.ffn_w_in = (const float*)d_in[15]; p.ffn_w_out = (const float*)d_in[16];
    p.out = (float*)d_out; p.ws = (unsigned char*)d_ws;
    void* args[] = {&p};
    hipError_t e = hipLaunchCooperativeKernel((const void*)hybrid_fwd, dim3(grid), dim3(NTHREADS), args, LDS_BYTES, stream);
    if (e != hipSuccess) fprintf(stderr, "kernel_launch: cooperative launch failed: %s (grid %d)\n", hipGetErrorString(e), grid);
}
```

```cpp
#include <hip/hip_runtime.h>
#include <hip/hip_cooperative_groups.h>
#include <cstdio>
#include <cstdint>
namespace cg = cooperative_groups;
namespace pg8 {
#define PG8_LAS __attribute__((address_space(3)))
typedef unsigned short bf16_t;
typedef short bf16x8 __attribute__((ext_vector_type(8)));
typedef float f32x4 __attribute__((ext_vector_type(4)));
typedef unsigned u32x4 __attribute__((ext_vector_type(4)));
constexpr int BM = 256, BK = 64, HALF = 128, HTB = HALF * BK * 2  , STAGE_BYTES = 8 * HTB, NXCD = 8, WGM = 8;

__host__ __device__ __forceinline__ int lds_byte(int r, int c) { const int st = (r >> 4) * 2 + (c >> 5), rr = r & 15, cc = c & 31, ob = rr * 64 + cc * 2; return st * 1024 + (ob ^ (((ob >> 9) & 1) << 5)); }
__host__ __device__ __forceinline__ void stage_rc(int b, int& R, int& C) { const int st = b / 1024, sb = b % 1024, swz = sb ^ (((sb >> 9) & 1) << 5); R = (st >> 1) * 16 + swz / 64; C = (st & 1) * 32 + (swz % 64) / 2; }
__host__ __device__ __forceinline__ int perm32(int rho) { const int n = rho >> 4, i = rho & 15; return 8 * (i >> 2) + 4 * n + (i & 3); }

struct Unit { int pm, pn; };
struct Gemm { const bf16_t* A; const bf16_t* Bt; int M, N, K; };

struct StaticOrder {
    int nM, nN, nwg, G, c;
    __host__ __device__ void init(int M, int N, int G_, int c_) { nM = M / BM; nN = N / BM; nwg = nM * nN; G = G_; c = c_; }
    __host__ __device__ bool next(int i, Unit& u) const {
        const long L = (long)i * G + c; if (L >= nwg) return false;
        int wgid = (int)L; { const int q = nwg / NXCD, r = nwg % NXCD, xcd = wgid % NXCD, off = wgid / NXCD; wgid = (xcd < r ? xcd * (q + 1) : r * (q + 1) + (xcd - r) * q) + off; }
        const int nig = WGM * nN, gid = wgid / nig, fm = gid * WGM, gsz = (nM - fm) < WGM ? (nM - fm) : WGM;
        u.pm = fm + ((wgid % nig) % gsz); u.pn = (wgid % nig) / gsz; return true;
    }
    __device__ __forceinline__ void a_ready(const Unit&) const {}
    __device__ __forceinline__ void done(const Unit&) const {}
};

__device__ __forceinline__ unsigned cvt_pk_bf16(float lo, float hi) { unsigned r; asm volatile("v_cvt_pk_bf16_f32 %0, %1, %2" : "=v"(r) : "v"(lo), "v"(hi)); return r; }
typedef float f32x2 __attribute__((ext_vector_type(2)));
template <class Epi, class Sched, bool ALIGN_EPI = false, bool SP2 = false>
__device__ __forceinline__ void gemm_phase(PG8_LAS unsigned char* lds, const Gemm g, const Sched& S, const Epi& E) {
    const int tid = threadIdx.x, wid = __builtin_amdgcn_readfirstlane(tid >> 6), lane = tid & 63, wr = wid >> 2, wc = wid & 3, fr = lane & 15, fq = lane >> 4;
    int Kx_ = g.K; asm volatile("" : "+s"(Kx_)); const int K = Kx_, nt = K / BK;
    unsigned voffA[2], voffB[2];
#pragma unroll
    for (int i = 0; i < 2; ++i) { int R, C; stage_rc(tid * 16 + i * 8192, R, C); const int Rb = Epi::PERM ? ((R & ~31) + perm32(R & 31)) : R;
        voffA[i] = (unsigned)(R * K + C) * 2u; voffB[i] = (unsigned)(Rb * K + C) * 2u; }
    const size_t kstep = (size_t)(BK * 2);
    const size_t hstep = (size_t)HALF * K * 2;
    const size_t tstep = 2 * hstep;
    const unsigned ldsw = (unsigned)wid * 1024u;
    const int aoff = lds_byte(wr * 64 + fr, fq * 8), boff = lds_byte(wc * 32 + fr, fq * 8);
#define PG8_SA(b, h) (((b) * 2 + (h)) * HTB)
#define PG8_SB(b, h) ((4 + (b) * 2 + (h)) * HTB)
#define PG8_STAGE(bufoff, gbase, voff) do { _Pragma("unroll") for (int _i = 0; _i < 2; ++_i) \
        __builtin_amdgcn_global_load_lds((const unsigned*)((const char*)(gbase) + (voff)[_i]), (PG8_LAS unsigned*)(lds + (bufoff) + ldsw + _i * 8192), 16, 0, 0); } while (0)
#define PG8_LDA(dst, b, h) do { _Pragma("unroll") for (int m = 0; m < 4; ++m) _Pragma("unroll") for (int k = 0; k < 2; ++k) dst[m][k] = *(const PG8_LAS bf16x8*)(lds + PG8_SA(b, h) + aoff + m * 2048 + k * 1024); } while (0)
#define PG8_LDB(dst, b, h) do { _Pragma("unroll") for (int n = 0; n < 2; ++n) _Pragma("unroll") for (int k = 0; k < 2; ++k) dst[n][k] = *(const PG8_LAS bf16x8*)(lds + PG8_SB(b, h) + boff + n * 2048 + k * 1024); } while (0)
#define PG8_MMA(ai, bj, At, Bt) do { __builtin_amdgcn_s_setprio(1); _Pragma("unroll") for (int m = 0; m < 4; ++m) _Pragma("unroll") for (int n = 0; n < 2; ++n) _Pragma("unroll") for (int k = 0; k < 2; ++k) \
        acc[ai][bj][m][n] = __builtin_amdgcn_mfma_f32_16x16x32_bf16(Bt[n][k], At[m][k], acc[ai][bj][m][n], 0, 0, 0); __builtin_amdgcn_s_setprio(0); } while (0)
#define PG8_WAIT_V(n) asm volatile("s_waitcnt vmcnt(" #n ")" ::: "memory")
#define PG8_WAIT_L(n) asm volatile("s_waitcnt lgkmcnt(" #n ")" ::: "memory")
#define PG8_BAR __builtin_amdgcn_s_barrier()
#define PG8_SCHED __builtin_amdgcn_sched_barrier(0)
    Unit cur, nxt; int ui = 0;
    if (!S.next(0, cur)) return;
    f32x4 acc[2][2][4][2];
#pragma unroll
    for (int a = 0; a < 2; ++a)
#pragma unroll
        for (int b = 0; b < 2; ++b)
#pragma unroll
            for (int m = 0; m < 4; ++m)
#pragma unroll
                for (int n = 0; n < 2; ++n) acc[a][b][m][n] = (f32x4){0.f, 0.f, 0.f, 0.f};
    bf16x8 At[4][2], B0[2][2], B1[2][2];
    const char* cA = (const char*)g.A + (size_t)cur.pm * tstep; const char* cB = (const char*)g.Bt + (size_t)cur.pn * tstep;
    S.a_ready(cur);
    if constexpr (SP2) {
        PG8_STAGE(PG8_SB(0, 0), cB, voffB); PG8_STAGE(PG8_SB(0, 1), cB + hstep, voffB); PG8_STAGE(PG8_SA(0, 0), cA, voffA); PG8_STAGE(PG8_SA(0, 1), cA + hstep, voffA);
        if (wr == 1) PG8_BAR;
        PG8_WAIT_V(2); PG8_BAR;
        PG8_STAGE(PG8_SB(1, 0), cB + kstep, voffB); PG8_STAGE(PG8_SA(1, 0), cA + kstep, voffA); PG8_STAGE(PG8_SB(1, 1), cB + hstep + kstep, voffB);
        PG8_WAIT_V(6); PG8_BAR;
    } else {
        PG8_STAGE(PG8_SB(0, 0), cB, voffB); PG8_STAGE(PG8_SA(0, 0), cA, voffA); PG8_STAGE(PG8_SB(0, 1), cB + hstep, voffB); PG8_STAGE(PG8_SA(0, 1), cA + hstep, voffA);
        if (wr == 1) PG8_BAR;
        PG8_WAIT_V(4); PG8_BAR;
        PG8_STAGE(PG8_SB(1, 0), cB + kstep, voffB); PG8_STAGE(PG8_SA(1, 0), cA + kstep, voffA); PG8_STAGE(PG8_SB(1, 1), cB + hstep + kstep, voffB);
        PG8_WAIT_V(6); PG8_BAR;
    }
    for (;;) {
        const bool has_next = S.next(ui + 1, nxt);
        const char* nA = has_next ? (const char*)g.A + (size_t)nxt.pm * tstep : cA; const char* nB = has_next ? (const char*)g.Bt + (size_t)nxt.pn * tstep : cB;
        for (int t = 0; t < nt; t += 2) {
            const bool last = (t == nt - 2);
            const char* a1 = cA + (size_t)(t + 1) * kstep;
            const char* a2 = last ? nA : cA + (size_t)(t + 2) * kstep; const char* b2 = last ? nB : cB + (size_t)(t + 2) * kstep;
            const char* a3 = a2 + kstep; const char* b3 = b2 + kstep;
            if (last && has_next) S.a_ready(nxt);
            if constexpr (SP2) {
            PG8_LDB(B0, 0, 0); PG8_LDB(B1, 0, 1); PG8_SCHED; PG8_LDA(At, 0, 0); PG8_STAGE(PG8_SA(1, 1), a1 + hstep, voffA);
            PG8_WAIT_V(8); PG8_WAIT_L(0); PG8_BAR; PG8_MMA(0, 0, At, B0); PG8_MMA(0, 1, At, B1); PG8_BAR; PG8_SCHED;
            PG8_LDA(At, 0, 1); PG8_STAGE(PG8_SB(0, 0), b2, voffB); PG8_STAGE(PG8_SB(0, 1), b2 + hstep, voffB); PG8_STAGE(PG8_SA(0, 0), a2, voffA);
            PG8_WAIT_V(8); PG8_WAIT_L(0); PG8_BAR; PG8_MMA(1, 0, At, B0); PG8_MMA(1, 1, At, B1); PG8_BAR; PG8_SCHED;
            PG8_LDB(B0, 1, 0); PG8_LDB(B1, 1, 1); PG8_SCHED; PG8_LDA(At, 1, 0); PG8_STAGE(PG8_SA(0, 1), a2 + hstep, voffA);
            PG8_WAIT_V(8); PG8_WAIT_L(0); PG8_BAR; PG8_MMA(0, 0, At, B0); PG8_MMA(0, 1, At, B1); PG8_BAR; PG8_SCHED;
            PG8_LDA(At, 1, 1); PG8_STAGE(PG8_SB(1, 0), b3, voffB); PG8_STAGE(PG8_SB(1, 1), b3 + hstep, voffB); PG8_STAGE(PG8_SA(1, 0), a3, voffA);
            PG8_WAIT_V(8); PG8_WAIT_L(0); PG8_BAR; PG8_MMA(1, 0, At, B0); PG8_MMA(1, 1, At, B1); PG8_BAR; PG8_SCHED;
            } else {
            PG8_LDB(B0, 0, 0); PG8_SCHED; PG8_LDA(At, 0, 0); PG8_STAGE(PG8_SA(1, 1), a1 + hstep, voffA);
            PG8_WAIT_L(8); PG8_BAR; PG8_WAIT_L(0); PG8_MMA(0, 0, At, B0); PG8_BAR; PG8_SCHED;
            PG8_LDB(B1, 0, 1); PG8_STAGE(PG8_SB(0, 0), b2, voffB);
            PG8_BAR; PG8_WAIT_L(0); PG8_MMA(0, 1, At, B1); PG8_BAR;
            PG8_LDA(At, 0, 1); PG8_STAGE(PG8_SA(0, 0), a2, voffA);
            PG8_BAR; PG8_WAIT_L(0); PG8_MMA(1, 0, At, B0); PG8_BAR; PG8_SCHED;
            PG8_STAGE(PG8_SB(0, 1), b2 + hstep, voffB);
            PG8_WAIT_V(6); PG8_BAR; PG8_MMA(1, 1, At, B1); PG8_BAR;
            PG8_LDB(B0, 1, 0); PG8_SCHED; PG8_LDA(At, 1, 0); PG8_STAGE(PG8_SA(0, 1), a2 + hstep, voffA);
            PG8_WAIT_L(8); PG8_BAR; PG8_WAIT_L(0); PG8_MMA(0, 0, At, B0); PG8_BAR; PG8_SCHED;
            PG8_LDB(B1, 1, 1); PG8_STAGE(PG8_SB(1, 0), b3, voffB);
            PG8_BAR; PG8_WAIT_L(0); PG8_MMA(0, 1, At, B1); PG8_BAR;
            PG8_LDA(At, 1, 1); PG8_STAGE(PG8_SA(1, 0), a3, voffA);
            PG8_BAR; PG8_WAIT_L(0); PG8_MMA(1, 0, At, B0); PG8_BAR; PG8_SCHED;
            PG8_STAGE(PG8_SB(1, 1), b3 + hstep, voffB);
            PG8_WAIT_V(6); PG8_BAR; PG8_MMA(1, 1, At, B1); PG8_BAR;
            }
        }
        if constexpr (ALIGN_EPI) { if (wr == 0) PG8_BAR; }
        if constexpr (!Epi::AFTER_DRAIN) { E(acc, cur, wr, wc, fr, fq); S.done(cur); }
        if (!has_next) break;
#pragma unroll
        for (int a = 0; a < 2; ++a)
#pragma unroll
            for (int b = 0; b < 2; ++b)
#pragma unroll
                for (int m = 0; m < 4; ++m)
#pragma unroll
                    for (int n = 0; n < 2; ++n) acc[a][b][m][n] = (f32x4){0.f, 0.f, 0.f, 0.f};
        cur = nxt; cA = nA; cB = nB; ++ui;
        if constexpr (ALIGN_EPI) { if (wr == 1) PG8_BAR; }
    }
    PG8_WAIT_V(0);
    if constexpr (!ALIGN_EPI) { if (wr == 0) PG8_BAR; }
    PG8_BAR;
    if constexpr (Epi::AFTER_DRAIN) { E.fused(acc, cur, wr, wc, fr, fq, lds, wid, lane); S.done(cur); }
#undef PG8_SA
#undef PG8_SB
#undef PG8_STAGE
#undef PG8_LDA
#undef PG8_LDB
#undef PG8_MMA
#undef PG8_WAIT_V
#undef PG8_WAIT_L
#undef PG8_BAR
#undef PG8_SCHED
}
}
namespace pg8 {
typedef unsigned u32x2 __attribute__((ext_vector_type(2)));
__device__ __forceinline__ float bf_lo(unsigned w) { return __uint_as_float(w << 16); }
__device__ __forceinline__ float bf_hi(unsigned w) { return __uint_as_float(w & 0xffff0000u); }
__device__ __forceinline__ float fast_sigmoid(float x) { return __builtin_amdgcn_rcpf(1.0f + __builtin_amdgcn_exp2f(-1.4426950408889634f * x)); }
__device__ __forceinline__ float gelu_tanh(float x) {
    const float u2 = 1.5957691216057308f * (x + 0.044715f * x * x * x);
    return x * fast_sigmoid(u2);
}
__device__ __forceinline__ u32x4 pack8(const f32x4 a, const f32x4 b) { u32x4 w; w.x = cvt_pk_bf16(a[0], a[1]); w.y = cvt_pk_bf16(a[2], a[3]); w.z = cvt_pk_bf16(b[0], b[1]); w.w = cvt_pk_bf16(b[2], b[3]); return w; }
constexpr float RMS_EPS = 1e-6f;
__device__ __forceinline__ float row_rstd(const float* ss, int row) {
    const f32x4* p = (const f32x4*)(ss + (size_t)row * 16); const f32x4 a = p[0], b = p[1], c = p[2], d = p[3];
    const float s = ((a[0] + a[1]) + (a[2] + a[3])) + ((b[0] + b[1]) + (b[2] + b[3])) + ((c[0] + c[1]) + (c[2] + c[3])) + ((d[0] + d[1]) + (d[2] + d[3]));
    return __builtin_amdgcn_rsqf(s * (1.0f / 1024.0f) + RMS_EPS);
}

__device__ __forceinline__ void wave_rstd8(const float* ss, int wave_row0  , int lane, int fr, float (&rs)[2][4]) {
    const f32x4* p0 = (const f32x4*)(ss + (size_t)(wave_row0 + lane) * 16); const f32x4* p1 = (const f32x4*)(ss + (size_t)(wave_row0 + HALF + lane) * 16);
    const f32x4 a0 = p0[0], b0 = p0[1], c0 = p0[2], d0 = p0[3], a1 = p1[0], b1 = p1[1], c1 = p1[2], d1 = p1[3];
    const float s0 = ((a0[0] + a0[1]) + (a0[2] + a0[3])) + ((b0[0] + b0[1]) + (b0[2] + b0[3])) + ((c0[0] + c0[1]) + (c0[2] + c0[3])) + ((d0[0] + d0[1]) + (d0[2] + d0[3]));
    const float s1 = ((a1[0] + a1[1]) + (a1[2] + a1[3])) + ((b1[0] + b1[1]) + (b1[2] + b1[3])) + ((c1[0] + c1[1]) + (c1[2] + c1[3])) + ((d1[0] + d1[1]) + (d1[2] + d1[3]));
    const float v0 = __builtin_amdgcn_rsqf(s0 * (1.0f / 1024.0f) + RMS_EPS), v1 = __builtin_amdgcn_rsqf(s1 * (1.0f / 1024.0f) + RMS_EPS);
#pragma unroll
    for (int m = 0; m < 4; ++m) { rs[0][m] = __shfl(v0, m * 16 + fr); rs[1][m] = __shfl(v1, m * 16 + fr); }
}

struct EpiLruIn {
    static constexpr bool PERM = true, AFTER_DRAIN = false;
    bf16_t* GB; bf16_t* RP; const float* bias;
    __device__ __forceinline__ void operator()(const f32x4 (&acc)[2][2][4][2], const Unit& u, int wr, int wc, int fr, int fq) const {
        const int row0 = u.pm * BM + wr * 64 + fr; const bool gate = u.pn < 4;
        const int colg = u.pn * BM + wc * 32 + 8 * fq; bf16_t* base = gate ? GB : RP; const int col0 = gate ? colg : colg - 1024;
        f32x4 bv[2][2];
#pragma unroll
        for (int bj = 0; bj < 2; ++bj)
#pragma unroll
            for (int n = 0; n < 2; ++n) bv[bj][n] = *(const f32x4*)(bias + colg + bj * HALF + 4 * n);
#pragma unroll
        for (int ai = 0; ai < 2; ++ai)
#pragma unroll
            for (int m = 0; m < 4; ++m) { bf16_t* rowp = base + (size_t)(row0 + ai * HALF + m * 16) * 1024 + col0;
#pragma unroll
                for (int bj = 0; bj < 2; ++bj) { f32x4 v0 = acc[ai][bj][m][0] + bv[bj][0], v1 = acc[ai][bj][m][1] + bv[bj][1];
                    if (gate) {
                        constexpr float k1 = -1.4426950408889634f * 1.5957691216057308f, k2 = k1 * 0.044715f;
                        const f32x4 t0 = v0 * (v0 * v0 * k2 + k1), t1 = v1 * (v1 * v1 * k2 + k1);
                        const f32x4 d0 = (f32x4){__builtin_amdgcn_exp2f(t0[0]), __builtin_amdgcn_exp2f(t0[1]), __builtin_amdgcn_exp2f(t0[2]), __builtin_amdgcn_exp2f(t0[3])} + 1.0f;
                        const f32x4 d1 = (f32x4){__builtin_amdgcn_exp2f(t1[0]), __builtin_amdgcn_exp2f(t1[1]), __builtin_amdgcn_exp2f(t1[2]), __builtin_amdgcn_exp2f(t1[3])} + 1.0f;
                        v0 = v0 * (f32x4){__builtin_amdgcn_rcpf(d0[0]), __builtin_amdgcn_rcpf(d0[1]), __builtin_amdgcn_rcpf(d0[2]), __builtin_amdgcn_rcpf(d0[3])};
                        v1 = v1 * (f32x4){__builtin_amdgcn_rcpf(d1[0]), __builtin_amdgcn_rcpf(d1[1]), __builtin_amdgcn_rcpf(d1[2]), __builtin_amdgcn_rcpf(d1[3])}; }
                    *(u32x4*)(rowp + bj * HALF) = pack8(v0, v1); } }
    }
};

struct EpiGate {
    static constexpr bool PERM = true, AFTER_DRAIN = false;
    const bf16_t* REC; const float* gate_b; const float* cn_tab; unsigned* AB; int M;
    __device__ __forceinline__ void operator()(const f32x4 (&acc)[2][2][4][2], const Unit& u, int wr, int wc, int fr, int fq) const {
        const int blk = u.pn >> 1, half = u.pn & 1;
        const int cl = half * 128 + wc * 32 + 8 * fq;
        const int ch0 = blk * 256 + cl;
        const int rowA0 = u.pm * BM + wr * 64 + fr;
        u32x4 rw[2][4];
#pragma unroll
        for (int ai = 0; ai < 2; ++ai)
#pragma unroll
            for (int m = 0; m < 4; ++m) rw[ai][m] = *(const u32x4*)(REC + (size_t)(rowA0 + ai * HALF + m * 16) * 256 + cl);
        f32x4 cn[2], gr[2], gi[2];
#pragma unroll
        for (int n = 0; n < 2; ++n) { cn[n] = *(const f32x4*)(cn_tab + ch0 + 4 * n); gr[n] = *(const f32x4*)(gate_b + ch0 + 4 * n); gi[n] = *(const f32x4*)(gate_b + 1024 + ch0 + 4 * n); }
#pragma unroll
        for (int ai = 0; ai < 2; ++ai)
#pragma unroll
            for (int m = 0; m < 4; ++m) {
                const int rowA = rowA0 + ai * HALF + m * 16; const int tok = rowA & (M - 1);
                const u32x4 r4 = rw[ai][m];
                const float rec[8] = {bf_lo(r4.x), bf_hi(r4.x), bf_lo(r4.y), bf_hi(r4.y), bf_lo(r4.z), bf_hi(r4.z), bf_lo(r4.w), bf_hi(r4.w)};
                u32x4 o[2];
#pragma unroll
                for (int n = 0; n < 2; ++n)
#pragma unroll
                    for (int e = 0; e < 4; ++e) {
                        const float r = fast_sigmoid(acc[ai][0][m][n][e] + gr[n][e]), ig = fast_sigmoid(acc[ai][1][m][n][e] + gi[n][e]);
                        const float la2 = cn[n][e] * r;
                        const float x = la2 * 1.3862943611198906f;
                        const float pm2 = -x * (1.0f + x * 0.5f * (1.0f + x * (1.0f / 3.0f) * (1.0f + x * 0.25f * (1.0f + x * 0.2f * (1.0f + x * (1.0f / 6.0f))))));
                        const float m2 = (x > -0.35f) ? pm2 : (1.0f - __builtin_amdgcn_exp2f(2.0f * la2));
                        const float bb = __builtin_sqrtf(fmaxf(m2, 0.0f)) * ig * rec[4 * n + e];
                        o[n][e] = cvt_pk_bf16(la2, bb); }
                unsigned* dp = AB + (size_t)tok * 1024 + ch0; *(u32x4*)dp = o[0]; *(u32x4*)(dp + 4) = o[1];
            }
    }
};

template <bool RES_BF16, bool OUT_F32, bool HAS_BIAS = false> struct EpiResid {
    static constexpr bool PERM = true, AFTER_DRAIN = false;
    const void* resid; float* OutF; bf16_t* OutB; float* SS; const float* bias;
    __device__ __forceinline__ void operator()(const f32x4 (&acc)[2][2][4][2], const Unit& u, int wr, int wc, int fr, int fq) const {
        const int row0 = u.pm * BM + wr * 64 + fr; const int col0 = u.pn * BM + wc * 32 + 8 * fq;
        f32x4 bv[2][2];
#pragma unroll
        for (int bj = 0; bj < 2; ++bj)
#pragma unroll
            for (int n = 0; n < 2; ++n) bv[bj][n] = HAS_BIAS ? *(const f32x4*)(bias + col0 + bj * HALF + 4 * n) : (f32x4){0.f, 0.f, 0.f, 0.f};
        constexpr int MG = RES_BF16 ? 2 : 1, NB = 8 / MG;
        u32x4 rb[2][MG][2]; f32x4 rf[2][MG][2][2];
        auto load_batch = [&](int k, int buf) {
#pragma unroll
            for (int mm = 0; mm < MG; ++mm)
#pragma unroll
                for (int bj = 0; bj < 2; ++bj) { const int g = k * MG + mm; const size_t off = (size_t)(row0 + (g >> 2) * HALF + (g & 3) * 16) * 1024 + col0 + bj * HALF;
                    if (RES_BF16) rb[buf][mm][bj] = *(const u32x4*)((const bf16_t*)resid + off);
                    else { rf[buf][mm][bj][0] = *(const f32x4*)((const float*)resid + off); rf[buf][mm][bj][1] = *(const f32x4*)((const float*)resid + off + 4); } } };
        load_batch(0, 0);
#pragma unroll
        for (int k = 0; k < NB; ++k) {
            const int cb = k & 1;
            if (k + 1 < NB) load_batch(k + 1, (k + 1) & 1);
#pragma unroll
            for (int mm = 0; mm < MG; ++mm) { const int g = k * MG + mm, ai = g >> 2, m = g & 3; const int row = row0 + ai * HALF + m * 16; const size_t off = (size_t)row * 1024 + col0; float ssq = 0.f;
#pragma unroll
                for (int bj = 0; bj < 2; ++bj) {
                    f32x4 r0, r1;
                    if (RES_BF16) { const u32x4 rw = rb[cb][mm][bj]; r0 = (f32x4){bf_lo(rw.x), bf_hi(rw.x), bf_lo(rw.y), bf_hi(rw.y)}; r1 = (f32x4){bf_lo(rw.z), bf_hi(rw.z), bf_lo(rw.w), bf_hi(rw.w)}; }
                    else { r0 = rf[cb][mm][bj][0]; r1 = rf[cb][mm][bj][1]; }
                    f32x4 v0 = acc[ai][bj][m][0] + r0, v1 = acc[ai][bj][m][1] + r1;
                    if (HAS_BIAS) { v0 = v0 + bv[bj][0]; v1 = v1 + bv[bj][1]; }
                    if (OUT_F32) { *(f32x4*)(OutF + off + bj * HALF) = v0; *(f32x4*)(OutF + off + bj * HALF + 4) = v1; }
                    else { *(u32x4*)(OutB + off + bj * HALF) = pack8(v0, v1);
                        ssq += (v0[0] * v0[0] + v0[1] * v0[1]) + (v0[2] * v0[2] + v0[3] * v0[3]) + (v1[0] * v1[0] + v1[1] * v1[1]) + (v1[2] * v1[2] + v1[3] * v1[3]); } }
                if (!OUT_F32) { ssq += __shfl_xor(ssq, 16); ssq += __shfl_xor(ssq, 32);
                    if (fq == 0) SS[(size_t)row * 16 + u.pn * 4 + wc] = ssq; } }
        }
    }
};

struct EpiSwiglu {
    static constexpr bool PERM = true, AFTER_DRAIN = false;
    const float* SS; bf16_t* HID; int ldh;
    __device__ __forceinline__ void operator()(const f32x4 (&acc)[2][2][4][2], const Unit& u, int wr, int wc, int fr, int fq) const {
        const int row0 = u.pm * BM + wr * 64 + fr; const int col0 = u.pn * HALF + wc * 32 + 8 * fq;
        float rsv[2][4]; wave_rstd8(SS, u.pm * BM + wr * 64, (int)(threadIdx.x & 63), fr, rsv);
#pragma unroll
        for (int ai = 0; ai < 2; ++ai)
#pragma unroll
            for (int m = 0; m < 4; ++m) { const int row = row0 + ai * HALF + m * 16; const float rs = rsv[ai][m];
                const float nrs = -1.4426950408889634f * rs, rsq = rs * rs;
                f32x4 h[2];
#pragma unroll
                for (int n = 0; n < 2; ++n) { const f32x4 g = acc[ai][0][m][n], up = acc[ai][1][m][n]; const f32x4 t = g * nrs;
                    f32x4 d = (f32x4){__builtin_amdgcn_exp2f(t[0]), __builtin_amdgcn_exp2f(t[1]), __builtin_amdgcn_exp2f(t[2]), __builtin_amdgcn_exp2f(t[3])} + 1.0f;
                    const f32x4 sg = (f32x4){__builtin_amdgcn_rcpf(d[0]), __builtin_amdgcn_rcpf(d[1]), __builtin_amdgcn_rcpf(d[2]), __builtin_amdgcn_rcpf(d[3])};
                    h[n] = ((g * up) * rsq) * sg; }
                *(u32x4*)(HID + (size_t)row * ldh + col0) = pack8(h[0], h[1]); }
    }
};

struct EpiQKV {
    static constexpr bool PERM = true, AFTER_DRAIN = false;
    const float* SS; bf16_t* Q; size_t tstride; float qscale;
    __device__ __forceinline__ void operator()(const f32x4 (&acc)[2][2][4][2], const Unit& u, int wr, int wc, int fr, int fq) const {
        const int row0 = u.pm * BM + wr * 64 + fr; const int t = u.pn >> 2; const int col0 = (u.pn & 3) * BM + wc * 32 + 8 * fq;
        bf16_t* base = Q + (size_t)t * tstride; const float sc = t == 0 ? qscale : 1.0f;
        float rsv[2][4]; wave_rstd8(SS, u.pm * BM + wr * 64, (int)(threadIdx.x & 63), fr, rsv);
#pragma unroll
        for (int ai = 0; ai < 2; ++ai)
#pragma unroll
            for (int m = 0; m < 4; ++m) { const int row = row0 + ai * HALF + m * 16; const float rs = rsv[ai][m] * sc;
#pragma unroll
                for (int bj = 0; bj < 2; ++bj) *(u32x4*)(base + (size_t)row * 1024 + col0 + bj * HALF) = pack8(acc[ai][bj][m][0] * rs, acc[ai][bj][m][1] * rs); }
    }
};

struct GateOrder {
    StaticOrder base;
    __device__ bool next(int i, Unit& u) const { if (!base.next(i, u)) return false; u.pn += 2 * (u.pm >> 7); return true; }
    __device__ __forceinline__ void a_ready(const Unit&) const {}
    __device__ __forceinline__ void done(const Unit&) const {}
};
}
namespace sba {
#define SB_LAS __attribute__((address_space(3)))
typedef unsigned short bf16_t;
typedef short bf16x8 __attribute__((ext_vector_type(8)));
typedef short s16x4 __attribute__((ext_vector_type(4)));
typedef float f32x16 __attribute__((ext_vector_type(16)));
typedef unsigned u32x4 __attribute__((ext_vector_type(4)));
typedef unsigned u32x2 __attribute__((ext_vector_type(2)));
constexpr int S = 4096, DM = 1024, PITCH = 144, TILE_B = 64 * PITCH, BUF_B = 2 * TILE_B;
constexpr int NSLOT = 5; constexpr int LDS_BYTES = NSLOT * BUF_B;
__device__ __forceinline__ unsigned cvtpk(float lo, float hi) { unsigned r; asm volatile("v_cvt_pk_bf16_f32 %0, %1, %2" : "=v"(r) : "v"(lo), "v"(hi)); return r; }
__device__ __forceinline__ s16x4 vtr(const SB_LAS unsigned char* p) { return __builtin_bit_cast(s16x4, __builtin_amdgcn_ds_read_tr16_b64_v4i16((SB_LAS s16x4*)p)); }

__device__ __forceinline__ void attn_unit(int b, int h, int qb, const bf16_t* Q, const bf16_t* K, const bf16_t* V, bf16_t* O, SB_LAS unsigned char* lds) {
    const int tid = threadIdx.x, lane = tid & 63, r32 = lane & 31, hi = lane >> 5; const int wid = __builtin_amdgcn_readfirstlane(tid >> 6);
    const size_t rowbase = (size_t)b * S; const int q0 = qb * 256; const int wq0 = q0 + wid * 32; const int qrow = wq0 + r32;
    SB_LAS int* flg = (SB_LAS int*)(lds + LDS_BYTES);
    __syncthreads();
    if (lane == 0) flg[wid] = 0x7fffffff;
    bool wdone = false;
    bf16x8 qf[4];
    { const bf16_t* Qw = Q + (rowbase + qrow) * DM + h * 64;
#pragma unroll
      for (int d0 = 0; d0 < 4; ++d0) qf[d0] = *(const bf16x8*)(Qw + d0 * 16 + hi * 8); }
    const int ldrow = tid >> 3, ldch = tid & 7;
    const bf16_t* kg = K + (rowbase + ldrow) * DM + h * 64 + ldch * 8; const bf16_t* vg = V + (rowbase + ldrow) * DM + h * 64 + ldch * 8;
    const int ldoff = ldrow * PITCH + ldch * 16;
    const int T0 = qb * 4;
    f32x16 o0 = {}, o1 = {}; float C = 1.0f;
    const int trq = (lane & 15) >> 2, trp = lane & 3, trblk = (lane >> 4) & 1;
    const int troff = (4 * hi + trq) * PITCH + (16 * trblk + 4 * trp) * 2;
    const int koff = r32 * PITCH + hi * 16;
    u32x4 kreg, vreg;
    {
        u32x4 k4[4], v4[4];
#pragma unroll
        for (int i = 0; i < 4; ++i) { const size_t go = (size_t)(T0 + i) * 64 * DM; k4[i] = *(const u32x4*)(kg + go); v4[i] = *(const u32x4*)(vg + go); }
#pragma unroll
        for (int i = 0; i < 4; ++i) { SB_LAS unsigned char* sb = lds + ((T0 + i) % NSLOT) * BUF_B; *(SB_LAS u32x4*)(sb + ldoff) = k4[i]; *(SB_LAS u32x4*)(sb + TILE_B + ldoff) = v4[i]; }
    }
    __syncthreads();
    const int pj = wid >> 1;
    for (int k = 0; ; ++k) {
        const int tnew = T0 - k - 1;
        if (tnew >= 0) { const size_t go = (size_t)tnew * 64 * DM; kreg = *(const u32x4*)(kg + go); vreg = *(const u32x4*)(vg + go); }
        const int kt = T0 + pj - k;
        if (!wdone && kt < 0) { wdone = true; if (lane == 0) flg[wid] = k; }
        if (!wdone) {
            const SB_LAS unsigned char* Kb = lds + (kt % NSLOT) * BUF_B; const SB_LAS unsigned char* Vb = Kb + TILE_B;
#pragma unroll
            for (int hf = 1; hf >= 0; --hf) {
                const int kb = 64 * kt + 32 * hf;
                if (kb < wq0 + 31) {
                    f32x16 p = {};
#pragma unroll
                    for (int d0 = 0; d0 < 4; ++d0) { const bf16x8 kf = *(const SB_LAS bf16x8*)(Kb + (32 * hf) * PITCH + koff + d0 * 32); p = __builtin_amdgcn_mfma_f32_32x32x16_bf16(kf, qf[d0], p, 0, 0, 0); }
                    s16x4 va[2][4];
                    { const SB_LAS unsigned char* vb = Vb + (32 * hf) * PITCH + troff;
#pragma unroll
                      for (int ks = 0; ks < 2; ++ks) { va[ks][0] = vtr(vb + (16 * ks) * PITCH); va[ks][1] = vtr(vb + (16 * ks + 8) * PITCH);
                          va[ks][2] = vtr(vb + (16 * ks) * PITCH + 64); va[ks][3] = vtr(vb + (16 * ks + 8) * PITCH + 64); } }
                    __builtin_amdgcn_sched_barrier(0);
                    if (kb + 31 >= wq0) {
                        asm volatile("" ::: "memory");
#pragma unroll
                        for (int r = 0; r < 16; ++r) { const int key = kb + (r & 3) + 8 * (r >> 2) + 4 * hi; if (key >= qrow) p[r] = -INFINITY; }
                    }
                    float dd[16], G[4];
#pragma unroll
                    for (int i = 0; i < 4; ++i) {
                        const float f3 = __builtin_amdgcn_rcpf(1.0f + __builtin_amdgcn_exp2f(p[4 * i + 3])), f2 = __builtin_amdgcn_rcpf(1.0f + __builtin_amdgcn_exp2f(p[4 * i + 2]));
                        const float f1 = __builtin_amdgcn_rcpf(1.0f + __builtin_amdgcn_exp2f(p[4 * i + 1])), f0 = __builtin_amdgcn_rcpf(1.0f + __builtin_amdgcn_exp2f(p[4 * i]));
                        const float L3 = f3, L2 = L3 * f2, L1 = L2 * f1, L0 = L1 * f0;
                        dd[4 * i + 3] = 1.0f - L3; dd[4 * i + 2] = L3 - L2; dd[4 * i + 1] = L2 - L1; dd[4 * i] = L1 - L0; G[i] = L0; }
                    float T[4], Hm[4];
#pragma unroll
                    for (int i = 0; i < 4; ++i) {
                        const auto rr = __builtin_amdgcn_permlane32_swap(__float_as_uint(G[i]), __float_as_uint(G[i]), false, false);
                        const float Lo = __uint_as_float(rr[0]), Hi_ = __uint_as_float(rr[1]); T[i] = Lo * Hi_; Hm[i] = hi ? 1.0f : Hi_; }
                    float Sx[4]; Sx[3] = C; Sx[2] = C * T[3]; Sx[1] = Sx[2] * T[2]; Sx[0] = Sx[1] * T[1];
                    C = Sx[0] * T[0];
                    float w[16];
#pragma unroll
                    for (int i = 0; i < 4; ++i) { const float E = Sx[i] * Hm[i]; w[4 * i + 3] = E * dd[4 * i + 3]; w[4 * i + 2] = E * dd[4 * i + 2]; w[4 * i + 1] = E * dd[4 * i + 1]; w[4 * i] = E * dd[4 * i]; }
                    u32x4 pw0, pw1;
                    pw0.x = cvtpk(w[0], w[1]); pw0.y = cvtpk(w[2], w[3]); pw0.z = cvtpk(w[4], w[5]); pw0.w = cvtpk(w[6], w[7]);
                    pw1.x = cvtpk(w[8], w[9]); pw1.y = cvtpk(w[10], w[11]); pw1.z = cvtpk(w[12], w[13]); pw1.w = cvtpk(w[14], w[15]);
                    const bf16x8 pa0 = __builtin_bit_cast(bf16x8, pw0), pa1 = __builtin_bit_cast(bf16x8, pw1);
#pragma unroll
                    for (int ks = 0; ks < 2; ++ks) {
                        const bf16x8 v0 = (bf16x8){va[ks][0][0], va[ks][0][1], va[ks][0][2], va[ks][0][3], va[ks][1][0], va[ks][1][1], va[ks][1][2], va[ks][1][3]};
                        const bf16x8 v1 = (bf16x8){va[ks][2][0], va[ks][2][1], va[ks][2][2], va[ks][2][3], va[ks][3][0], va[ks][3][1], va[ks][3][2], va[ks][3][3]};
                        o0 = __builtin_amdgcn_mfma_f32_32x32x16_bf16(v0, ks ? pa1 : pa0, o0, 0, 0, 0);
                        o1 = __builtin_amdgcn_mfma_f32_32x32x16_bf16(v1, ks ? pa1 : pa0, o1, 0, 0, 0);
                    }
                }
            }
            if (__builtin_amdgcn_ballot_w64(C != 0.0f) == 0ull) { wdone = true; if (lane == 0) flg[wid] = k; }
        }
        if (tnew >= 0) { SB_LAS unsigned char* nb = lds + (tnew % NSLOT) * BUF_B; *(SB_LAS u32x4*)(nb + ldoff) = kreg; *(SB_LAS u32x4*)(nb + TILE_B + ldoff) = vreg; }
        __syncthreads();
        { typedef int i32x4 __attribute__((ext_vector_type(4))); const i32x4 fa = *(const SB_LAS i32x4*)flg, fb = *(const SB_LAS i32x4*)(flg + 4);
          const int mx = max(max(max(fa.x, fa.y), max(fa.z, fa.w)), max(max(fb.x, fb.y), max(fb.z, fb.w)));
          if (mx <= k) break; }
    }
    { typedef float f32x2_t __attribute__((ext_vector_type(2))); typedef __bf16 bf16x2_t __attribute__((ext_vector_type(2)));
      auto pk = [](float lo, float hi_) -> unsigned { const f32x2_t v = {lo, hi_}; return __builtin_bit_cast(unsigned, __builtin_convertvector(v, bf16x2_t)); };
      bf16_t* Orow = O + (rowbase + qrow) * DM + h * 64 + (hi ? 8 : 0);
#pragma unroll
      for (int dh = 0; dh < 2; ++dh) {
          const f32x16& o = dh ? o1 : o0;
#pragma unroll
          for (int k = 0; k < 4; k += 2) {
              unsigned ax = pk(o[4 * k], o[4 * k + 1]), ay = pk(o[4 * k + 2], o[4 * k + 3]), bx = pk(o[4 * k + 4], o[4 * k + 5]), by = pk(o[4 * k + 6], o[4 * k + 7]);
              { const auto r = __builtin_amdgcn_permlane32_swap(ax, bx, false, false); ax = r[0]; bx = r[1]; }
              { const auto r = __builtin_amdgcn_permlane32_swap(ay, by, false, false); ay = r[0]; by = r[1]; }
              u32x4 w; w.x = ax; w.y = ay; w.z = bx; w.w = by;
              *(u32x4*)(Orow + dh * 32 + 8 * k) = w; } } }
}
__device__ __forceinline__ void attn_phase(int vcu, int G, const bf16_t* Q, const bf16_t* K, const bf16_t* V, bf16_t* O, SB_LAS unsigned char* lds) {
    for (int v = vcu; v < 256; v += G) {
        const int bh = v >> 1, par = v & 1;
        for (int j = 0; j < 4; ++j) { const int s = 2 * j + par;
            attn_unit(bh >> 4, bh & 15, 15 - s, Q, K, V, O, lds);
            attn_unit(bh >> 4, bh & 15, s, Q, K, V, O, lds); }
    }
}
}
namespace lru {
#define LR_LAS __attribute__((address_space(3)))
typedef unsigned short bf16_t;
typedef short bf16x8 __attribute__((ext_vector_type(8)));
typedef float f32x16 __attribute__((ext_vector_type(16)));
typedef float f32x4 __attribute__((ext_vector_type(4)));
typedef unsigned u32x4 __attribute__((ext_vector_type(4)));
constexpr int SEQ = 4096, DM = 1024, AP = 528, A_OFF = 0, B_OFF = 128 * AP, U_OFF = B_OFF + 64 * AP, HP = 36, W_OFF = U_OFF + 128 * HP * 4, LDS_END = W_OFF + 1024;
static_assert(LDS_END <= 131072, "lru phase LDS");
__device__ __forceinline__ float lo16(unsigned w) { return __uint_as_float(w << 16); }
__device__ __forceinline__ float hi16(unsigned w) { return __uint_as_float(w & 0xffff0000u); }
__device__ __forceinline__ unsigned cvtpk(float lo, float hi) { unsigned r; asm volatile("v_cvt_pk_bf16_f32 %0, %1, %2" : "=v"(r) : "v"(lo), "v"(hi)); return r; }
__device__ __forceinline__ float sigm(float x) { return __builtin_amdgcn_rcpf(1.0f + __builtin_amdgcn_exp2f(-1.4426950408889634f * x)); }
__device__ __forceinline__ float fmac(float a, float b, float c) { asm("v_fmac_f32 %0, %1, %2" : "+v"(c) : "v"(a), "v"(b)); return c; }
#define LR_SWAP(x, L, H) do { const auto rr_ = __builtin_amdgcn_permlane32_swap(__float_as_uint(x), __float_as_uint(x), false, false); L = __uint_as_float(rr_[0]); H = __uint_as_float(rr_[1]); } while (0)

__device__ __forceinline__ void lru_phase(int vcu, int G, const bf16_t* REC  , int Mtot, const bf16_t* RP_unused, const bf16_t* GB, bf16_t* Y, const bf16_t* GwT, const float* conv_w, const float* conv_b, const float* gate_b, const float* CN2,
                                          LR_LAS unsigned char* lds) {
    const int tid = threadIdx.x, lane = tid & 63, r32 = lane & 31, hi = lane >> 5; const int wid = __builtin_amdgcn_readfirstlane(tid >> 6);
    const int role = wid >> 2, tg = wid & 3;
    LR_LAS float* U = (LR_LAS float*)(lds + U_OFF); LR_LAS float* Hs = U; LR_LAS float* WAGG = (LR_LAS float*)(lds + W_OFF);
    for (int it = vcu; it < 256; it += G) {
        const int s = it & 7, blk = (it >> 3) & 3, b = it >> 5;
        const int chb = blk * 256, ch0 = chb + s * 32;
        const size_t rowb = (size_t)b * SEQ;
        __syncthreads();
        {
            const int n = tid >> 3, q = tid & 7, g = n >> 5, c = n & 31, d = s * 32 + c;
            const bf16_t* src = GwT + ((size_t)((blk * 2 + (d >> 7)) * 256 + g * 128 + (d & 127))) * 256 + q * 32;
#pragma unroll
            for (int j = 0; j < 4; ++j) *(LR_LAS u32x4*)(lds + B_OFF + n * AP + q * 64 + j * 16) = *(const u32x4*)(src + j * 8);
        }
        const int cc = tid & 31, tg8 = tid >> 5, cch = chb + cc * 8;
        const float gbias = gate_b[role * 1024 + ch0 + r32], cn2 = CN2[ch0 + r32];
        float carry = 0.0f;
        const bool all_small = __builtin_amdgcn_ballot_w64(!(cn2 * 1.3862943611198906f > -0.35f)) == 0ull;
        const bf16_t* recb = REC + ((size_t)blk * Mtot + rowb) * 256 + cc * 8;
        u32x4 win[8];
#pragma unroll
        for (int i = 0; i < 8; ++i) win[i] = *(const u32x4*)(recb + (size_t)(8 * tg8 + i) * 256);
        for (int tile = 0; tile < SEQ / 128; ++tile) {
            const int t0 = tile * 128;
#pragma unroll
            for (int j = 0; j < 8; ++j) *(LR_LAS u32x4*)(lds + A_OFF + (8 * tg8 + j) * AP + cc * 16) = win[j];
            __syncthreads();
            if (tile + 1 < SEQ / 128) {
#pragma unroll
                for (int i = 0; i < 8; ++i) win[i] = *(const u32x4*)(recb + (size_t)(t0 + 128 + 8 * tg8 + i) * 256); }
            const u32x4 gbv = *(const u32x4*)(GB + (rowb + t0 + (tid >> 2)) * DM + ch0 + (tid & 3) * 8);
            f32x16 acc = {};
            { const LR_LAS unsigned char* ap = lds + A_OFF + (32 * tg + r32) * AP + hi * 16; const LR_LAS unsigned char* bp = lds + B_OFF + (role * 32 + r32) * AP + hi * 16;
#pragma unroll
              for (int ks = 0; ks < 16; ++ks) acc = __builtin_amdgcn_mfma_f32_32x32x16_bf16(*(const LR_LAS bf16x8*)(ap + ks * 32), *(const LR_LAS bf16x8*)(bp + ks * 32), acc, 0, 0, 0); }
            float av[16], bv[16];
            if (role) {
#pragma unroll
                for (int r = 0; r < 16; ++r) { const int tl = 32 * tg + (r & 3) + 8 * (r >> 2) + 4 * hi;
                    const float rec = __uint_as_float((unsigned)(*(const LR_LAS unsigned short*)(lds + A_OFF + tl * AP + (s * 32 + r32) * 2)) << 16);
                    U[(tg * 16 + r) * 64 + lane] = sigm(acc[r] + gbias) * rec; }
            } else {
#pragma unroll
                for (int r = 0; r < 16; ++r) { const float la2 = cn2 * sigm(acc[r] + gbias);
                    av[r] = __builtin_amdgcn_exp2f(la2);
                    const float x = la2 * 1.3862943611198906f;
                    const float pm2 = -x * (1.0f + x * 0.5f * (1.0f + x * (1.0f / 3.0f) * (1.0f + x * 0.25f * (1.0f + x * 0.2f * (1.0f + x * (1.0f / 6.0f))))));
                    bv[r] = pm2; }
                if (!all_small) {
#pragma unroll
                    for (int r = 0; r < 16; ++r) if (__builtin_amdgcn_logf(av[r]) * 1.3862943611198906f <= -0.35f) bv[r] = fmaxf(1.0f - av[r] * av[r], 0.0f); }
#pragma unroll
                for (int r = 0; r < 16; ++r) bv[r] = __builtin_amdgcn_sqrtf(bv[r]);
            }
            __syncthreads();
            float PA[4], PB[4];
            if (!role) {
#pragma unroll
                for (int r = 0; r < 16; ++r) bv[r] *= U[(tg * 16 + r) * 64 + lane];
                float XA = 1.0f, XB = 0.0f;
#pragma unroll
                for (int i = 0; i < 4; ++i) {
                    float Ag = av[4 * i], Bg = bv[4 * i];
#pragma unroll
                    for (int k = 1; k < 4; ++k) { Bg = av[4 * i + k] * Bg + bv[4 * i + k]; Ag *= av[4 * i + k]; }
                    float AL, AH, BL, BH; LR_SWAP(Ag, AL, AH); LR_SWAP(Bg, BL, BH);
                    const float tA = XA * AL, tB = AL * XB + BL;
                    PA[i] = hi ? tA : XA; PB[i] = hi ? tB : XB;
                    XA = tA * AH; XB = AH * tB + BH; }
                if (hi == 0) { WAGG[(tg * 2) * 32 + r32] = XA; WAGG[(tg * 2 + 1) * 32 + r32] = XB; }
            }
            __syncthreads();
            if (!role) {
                float hin = carry;
#pragma unroll
                for (int t4 = 0; t4 < 4; ++t4) { const float wa = WAGG[(t4 * 2) * 32 + r32], wb = WAGG[(t4 * 2 + 1) * 32 + r32]; if (t4 < tg) hin = wa * hin + wb; carry = wa * carry + wb; }
#pragma unroll
                for (int i = 0; i < 4; ++i) { float h = PA[i] * hin + PB[i];
#pragma unroll
                    for (int k = 0; k < 4; ++k) { h = av[4 * i + k] * h + bv[4 * i + k]; Hs[(32 * tg + k + 8 * i + 4 * hi) * HP + r32] = h; } }
            }
            __syncthreads();
            { const LR_LAS float* hp = Hs + (tid >> 2) * HP + (tid & 3) * 8; const f32x4 h0 = *(const LR_LAS f32x4*)hp, h1 = *(const LR_LAS f32x4*)(hp + 4);
              u32x4 y; y.x = cvtpk(lo16(gbv.x) * h0.x, hi16(gbv.x) * h0.y); y.y = cvtpk(lo16(gbv.y) * h0.z, hi16(gbv.y) * h0.w); y.z = cvtpk(lo16(gbv.z) * h1.x, hi16(gbv.z) * h1.y); y.w = cvtpk(lo16(gbv.w) * h1.z, hi16(gbv.w) * h1.w);
              *(u32x4*)(Y + (rowb + t0 + (tid >> 2)) * DM + ch0 + (tid & 3) * 8) = y; }
        }
    }
}
}
#ifndef DUP_MASK
#define DUP_MASK 0u
#endif
#ifndef SYNC_REPS
#define SYNC_REPS 1
#endif
#define GSYNC() do { for (int s_ = 0; s_ < SYNC_REPS; ++s_) xcd_barrier(bar); } while (0)
constexpr int NWAVES = 8, NTHREADS = 512;
constexpr int BATCH = 8, SEQ = 4096, D = 1024, M = BATCH * SEQ, FF = 2816, NFF2 = 2 * FF, NLRU2 = 2048, NQKV = 3072;
constexpr size_t MiB = 1u << 20;
constexpr size_t WS_WIN = 1 * MiB, WS_GW = 5 * MiB, WS_WOUT = 6 * MiB, WS_WQKV = 8 * MiB, WS_WO = 14 * MiB, WS_W1 = 16 * MiB  , WS_W2 = 38 * MiB  ;
constexpr size_t WS_CN = 49 * MiB;
constexpr size_t WS_SS = 50 * MiB  , WS_AGG = 58 * MiB  ;
constexpr size_t WS_XN0 = 64 * MiB, WS_RP = 128 * MiB, WS_A = 64 * MiB  , WS_GB = 192 * MiB, WS_REC = 256 * MiB, WS_B = 320 * MiB  ;
constexpr size_t WS_Y = 256 * MiB, WS_H = 64 * MiB  , WS_HB = 192 * MiB, WS_HID = 256 * MiB  ;
constexpr size_t WS_Q = 256 * MiB, WS_K = 320 * MiB, WS_V = 384 * MiB, WS_O = 448 * MiB, WS_END = 512 * MiB;
constexpr int MISC_OFF = 131072 + 320;
constexpr size_t WS_CTL = 0;
constexpr int LDS_BYTES = 147456;

#define LAS __attribute__((address_space(3)))
#define GAS __attribute__((address_space(1)))
typedef GAS unsigned gu32;
typedef GAS unsigned long long gu64;
#define RLX_AGENT __ATOMIC_RELAXED, __HIP_MEMORY_SCOPE_AGENT
#define LDS_WAIT() asm volatile("s_waitcnt lgkmcnt(0)" ::: "memory")
#define VM_WAIT() asm volatile("s_waitcnt vmcnt(0)" ::: "memory")
__device__ __forceinline__ unsigned long long rt() { return __builtin_amdgcn_s_memrealtime(); }

#define XB_TMO      128
#define XB_XCNT(j)  (256  + 64 * (j))
#define XB_XSUB(j)  (1280 + 64 * (j))
#define XB_XGEN(j)  (2304 + 64 * (j))
#define XB_TOP      3328
#define XB_TOPGEN   3392
#define XCD_BAR_WORDS 3456
#define XB_SPIN_CAP (1u << 18)

__device__ __forceinline__ unsigned xb_ld(unsigned* p)              { return __hip_atomic_load(p, __ATOMIC_RELAXED, __HIP_MEMORY_SCOPE_AGENT); }
__device__ __forceinline__ unsigned xb_add(unsigned* p, unsigned v) { return __hip_atomic_fetch_add(p, v, __ATOMIC_RELAXED, __HIP_MEMORY_SCOPE_AGENT); }
__device__ __forceinline__ unsigned xb_xcc_id() { return (unsigned)__builtin_amdgcn_s_getreg((3 << 11) | 20) & 0xFu; }
#define XB_SPIN(cond, bar) do { unsigned _sp = 0; while (cond) { __builtin_amdgcn_s_sleep(1); \
    if ((++_sp & 255u) == 0u) { if (xb_ld(&(bar)[XB_TMO])) break; if (_sp > XB_SPIN_CAP) { atomicAdd(&(bar)[XB_TMO], 1u); break; } } } } while (0)

struct XcdBarrier {
    unsigned* bar; unsigned x;
    volatile LAS unsigned* st;
};

__device__ __forceinline__ XcdBarrier xcd_barrier_post(unsigned* bar, volatile LAS unsigned* st) {
    XcdBarrier b; b.bar = bar; b.x = xb_xcc_id(); b.st = st;
    if (threadIdx.x == 0) (void)xb_add(&bar[XB_XCNT(b.x)], 1u);
    return b;
}
__device__ __forceinline__ void xcd_barrier_complete(unsigned* bar, unsigned x, unsigned& nloc, unsigned& nx) {
    const unsigned G = gridDim.x * gridDim.y * gridDim.z;
    unsigned sum, cnt, mine, sp = 0u;
    for (;;) {
        sum = 0u; cnt = 0u; mine = 0u;
#pragma unroll
        for (unsigned j = 0; j < 16; ++j) { const unsigned c = xb_ld(&bar[XB_XCNT(j)]); sum += c; cnt += (c > 0u) ? 1u : 0u; mine = (j == x) ? c : mine; }
        if (sum == G) break;
        __builtin_amdgcn_s_sleep(1);
        if ((++sp & 255u) == 0u) { if (xb_ld(&bar[XB_TMO])) break; if (sp > XB_SPIN_CAP) { atomicAdd(&bar[XB_TMO], 1u); break; } }
    }
    nloc = mine > 0u ? mine : 1u; nx = cnt > 0u ? cnt : 1u;
}

__device__ __forceinline__ void xcd_barrier(const XcdBarrier& b) {
    asm volatile("s_waitcnt vmcnt(0)" ::: "memory");
    __syncthreads();
    if (threadIdx.x == 0) {
        unsigned* bar = b.bar;
        __builtin_amdgcn_s_waitcnt(0);
        unsigned nloc = b.st[0], nx = b.st[1];
        if (nloc == 0u) { xcd_barrier_complete(bar, b.x, nloc, nx); b.st[0] = nloc; b.st[1] = nx; }
        const unsigned old = xb_add(&bar[XB_XSUB(b.x)], 1u);
        const unsigned gen = old / nloc;
        if (old + 1u == (gen + 1u) * nloc) {
            __builtin_amdgcn_fence(__ATOMIC_RELEASE, "agent");
            asm volatile("s_waitcnt vmcnt(0)" ::: "memory");
            const unsigned og = xb_add(&bar[XB_TOP], 1u);
            const unsigned tg = og / nx;
            if (og + 1u == (tg + 1u) * nx) xb_add(&bar[XB_TOPGEN], 1u);
            else XB_SPIN(xb_ld(&bar[XB_TOPGEN]) == tg, bar);
            __builtin_amdgcn_fence(__ATOMIC_ACQUIRE, "agent");
            xb_add(&bar[XB_XGEN(b.x)], 1u);
            asm volatile("s_waitcnt vmcnt(0)" ::: "memory");
        } else {
            XB_SPIN(xb_ld(&bar[XB_XGEN(b.x)]) == gen, bar);
            __builtin_amdgcn_fence(__ATOMIC_ACQUIRE, "agent");
            asm volatile("s_waitcnt vmcnt(0)" ::: "memory");
        }
    }
    __syncthreads();
}

typedef unsigned short bf16;
typedef unsigned v4u __attribute__((ext_vector_type(4)));
typedef unsigned v2u __attribute__((ext_vector_type(2)));
typedef float f32x4 __attribute__((ext_vector_type(4)));
__device__ __forceinline__ unsigned f2bf(float f) { unsigned u = __builtin_bit_cast(unsigned, f); return (u + 0x7fffu + ((u >> 16) & 1u)) >> 16; }
__device__ __forceinline__ unsigned pk2(float lo, float hi) { typedef float f32x2_t __attribute__((ext_vector_type(2))); typedef __bf16 bf16x2_t __attribute__((ext_vector_type(2)));
    const f32x2_t v = {lo, hi}; return __builtin_bit_cast(unsigned, __builtin_convertvector(v, bf16x2_t)); }
__device__ __forceinline__ float bflo(unsigned w) { return __uint_as_float(w << 16); }
__device__ __forceinline__ float bfhi(unsigned w) { return __uint_as_float(w & 0xffff0000u); }
__device__ __forceinline__ float wave_sum(float v) {
#pragma unroll
    for (int o = 1; o < 64; o <<= 1) v += __shfl_xor(v, o);
    return v;
}

struct Params {
    const float *x, *mix_norm, *ffn_norm, *final_norm, *lru_w_in, *lru_b_in, *lru_conv_w, *lru_conv_b, *lru_gate_w, *lru_gate_b, *lru_lambda, *lru_w_out, *lru_b_out,
                *attn_w_qkv, *attn_w_o, *ffn_w_in, *ffn_w_out;
    float* out; unsigned char* ws;
};

__device__ __forceinline__ void transpose_item(const float* W, int K, int N, bf16* WT, const float* gain, int mode, int base, int split, LAS float* scr, int item, int lane) {
    const int nblk = N / 64, kb = item / nblk, nb = item % nblk, k0 = 32 * kb, n0 = 64 * nb;
    const int lr = lane >> 4, lc = (lane & 15) * 4;
    f32x4 v[8];
#pragma unroll
    for (int i = 0; i < 8; ++i) v[i] = *(const f32x4*)(W + (size_t)(k0 + 4 * i + lr) * N + n0 + lc);
#pragma unroll
    for (int i = 0; i < 8; ++i) { const int kk = 4 * i + lr; const float g = gain ? gain[k0 + kk] : 1.0f; LAS float* d = scr + kk * 65 + lc; d[0] = v[i].x * g; d[1] = v[i].y * g; d[2] = v[i].z * g; d[3] = v[i].w * g; }
    asm volatile("s_waitcnt lgkmcnt(0)" ::: "memory");
    const int c = lane & 3;
#pragma unroll
    for (int j = 0; j < 4; ++j) { const int nl = (lane >> 2) + 16 * j; const int n = n0 + nl; const LAS float* s = scr + (8 * c) * 65 + nl;
        int dr; if (mode == 0) dr = base + n; else { const int hi_ = n >= split; const int nn = hi_ ? n - split : n; dr = base + (hi_ ? 128 : 0) + (nn >> 7) * 256 + (nn & 127); }
        v4u o; o.x = pk2(s[0 * 65], s[1 * 65]); o.y = pk2(s[2 * 65], s[3 * 65]); o.z = pk2(s[4 * 65], s[5 * 65]); o.w = pk2(s[6 * 65], s[7 * 65]);
        *(v4u*)(WT + (size_t)dr * K + k0 + 8 * c) = o; }
    asm volatile("s_waitcnt lgkmcnt(0)" ::: "memory");
}

__device__ __forceinline__ void rms_row_to_bf16(const float* xrow, const float* g, bf16* orow, int lane) {
    const f32x4* xr = (const f32x4*)xrow + lane; const f32x4* gr = (const f32x4*)g + lane;
    f32x4 v[4]; float s = 0.f;
#pragma unroll
    for (int j = 0; j < 4; ++j) { v[j] = xr[64 * j]; s += (v[j].x * v[j].x + v[j].y * v[j].y) + (v[j].z * v[j].z + v[j].w * v[j].w); }
    const float rstd = 1.0f / sqrtf(wave_sum(s) * (1.f / D) + 1e-6f);
    unsigned long long* o8 = (unsigned long long*)orow + lane;
#pragma unroll
    for (int j = 0; j < 4; ++j) { const f32x4 gg = gr[64 * j]; o8[64 * j] = (unsigned long long)pk2(v[j].x * rstd * gg.x, v[j].y * rstd * gg.y) | ((unsigned long long)pk2(v[j].z * rstd * gg.z, v[j].w * rstd * gg.w) << 32); }
}
__device__ __forceinline__ void rms_row2_to_bf16(const float* xrow, const float* g, bf16* orow, int lane) {
    const f32x4* xr = (const f32x4*)xrow + lane; const f32x4* gr = (const f32x4*)g + lane;
    f32x4 v[8], gv[4]; float s0 = 0.f, s1 = 0.f;
#pragma unroll
    for (int j = 0; j < 8; ++j) v[j] = xr[64 * j];
#pragma unroll
    for (int j = 0; j < 4; ++j) gv[j] = gr[64 * j];
#pragma unroll
    for (int j = 0; j < 4; ++j) { s0 += (v[j].x * v[j].x + v[j].y * v[j].y) + (v[j].z * v[j].z + v[j].w * v[j].w); s1 += (v[4 + j].x * v[4 + j].x + v[4 + j].y * v[4 + j].y) + (v[4 + j].z * v[4 + j].z + v[4 + j].w * v[4 + j].w); }
    const float r0 = 1.0f / sqrtf(wave_sum(s0) * (1.f / D) + 1e-6f), r1 = 1.0f / sqrtf(wave_sum(s1) * (1.f / D) + 1e-6f);
    unsigned long long* o8 = (unsigned long long*)orow + lane;
#pragma unroll
    for (int j = 0; j < 4; ++j) { const f32x4 gg = gv[j];
        o8[64 * j] = (unsigned long long)pk2(v[j].x * r0 * gg.x, v[j].y * r0 * gg.y) | ((unsigned long long)pk2(v[j].z * r0 * gg.z, v[j].w * r0 * gg.w) << 32);
        o8[256 + 64 * j] = (unsigned long long)pk2(v[4 + j].x * r1 * gg.x, v[4 + j].y * r1 * gg.y) | ((unsigned long long)pk2(v[4 + j].z * r1 * gg.z, v[4 + j].w * r1 * gg.w) << 32); }
}
__device__ __forceinline__ void final_row(const bf16* hrow, const float* ss16, const float* g, float* orow, int lane) {
    const f32x4* sp = (const f32x4*)ss16; const f32x4 a = sp[0], b = sp[1], c = sp[2], d = sp[3];
    const float s = ((a.x + a.y) + (a.z + a.w)) + ((b.x + b.y) + (b.z + b.w)) + ((c.x + c.y) + (c.z + c.w)) + ((d.x + d.y) + (d.z + d.w));
    const float rstd = 1.0f / sqrtf(s * (1.f / D) + 1e-6f);
#pragma unroll
    for (int j = 0; j < 2; ++j) { const v4u w = *((const v4u*)hrow + lane + 64 * j); const f32x4 g0 = *((const f32x4*)g + 2 * lane + 128 * j), g1 = *((const f32x4*)g + 2 * lane + 128 * j + 1);
        f32x4* o = (f32x4*)orow + 2 * lane + 128 * j;
        o[0] = (f32x4){bflo(w.x) * rstd * g0.x, bfhi(w.x) * rstd * g0.y, bflo(w.y) * rstd * g0.z, bfhi(w.y) * rstd * g0.w};
        o[1] = (f32x4){bflo(w.z) * rstd * g1.x, bfhi(w.z) * rstd * g1.y, bflo(w.w) * rstd * g1.z, bfhi(w.w) * rstd * g1.w}; }
}

__global__ void __launch_bounds__(NTHREADS, 2) hybrid_fwd(Params p) {
    extern __shared__ __attribute__((aligned(16))) unsigned char lds_raw[];
    LAS unsigned char* lds = (LAS unsigned char*)lds_raw;
    cg::grid_group grid = cg::this_grid();
    volatile LAS unsigned* MISC = (volatile LAS unsigned*)(lds + MISC_OFF);
    if (threadIdx.x < 32) MISC[threadIdx.x] = 0u;
    __syncthreads();
    const int tid = threadIdx.x, lane = tid & 63, wave = __builtin_amdgcn_readfirstlane(tid >> 6);
    const int G = gridDim.x, bx = blockIdx.x; const int vcu = (G % 8 == 0) ? (bx % 8) * (G / 8) + bx / 8 : bx;
    const int gw = vcu * NWAVES + wave, NGW = G * NWAVES; const int gt = vcu * NTHREADS + tid, NGT = G * NTHREADS;
    unsigned char* ws = p.ws;
    bf16 *WinT = (bf16*)(ws + WS_WIN), *GwT = (bf16*)(ws + WS_GW), *WoutT = (bf16*)(ws + WS_WOUT), *WqkvT = (bf16*)(ws + WS_WQKV), *WoT = (bf16*)(ws + WS_WO), *W1T = (bf16*)(ws + WS_W1), *W2T = (bf16*)(ws + WS_W2);
    float* SS = (float*)(ws + WS_SS); float* AGGA = (float*)(ws + WS_AGG); float* AGGB = AGGA + (size_t)BATCH * 64 * D;
    bf16 *XN0 = (bf16*)(ws + WS_XN0), *RP = (bf16*)(ws + WS_RP), *GB = (bf16*)(ws + WS_GB), *REC = (bf16*)(ws + WS_REC), *Y = (bf16*)(ws + WS_Y), *HB = (bf16*)(ws + WS_HB), *HID = (bf16*)(ws + WS_HID);
    bf16 *Qb = (bf16*)(ws + WS_Q), *Kb = (bf16*)(ws + WS_K), *Vb = (bf16*)(ws + WS_V), *Ob = (bf16*)(ws + WS_O);
    float* CN = (float*)(ws + WS_CN);
    unsigned* AB = (unsigned*)(ws + WS_B);
    constexpr size_t SS_STRIDE = (size_t)M * 16;

    for (int rep_ = 0; rep_ < 1 + ((DUP_MASK >> 0) & 1); ++rep_) {
        LAS float* scr = (LAS float*)(lds + wave * 16384);
        constexpr int I_WIN = (D / 32) * (NLRU2 / 64), I_G1 = (256 / 32) * (256 / 64), I_G = 8 * I_G1, I_SQ = (D / 32) * (D / 64), I_QKV = (D / 32) * (NQKV / 64), I_W1 = (D / 32) * (NFF2 / 64), I_W2 = (FF / 32) * (D / 64);
        constexpr int NITEMS = I_WIN + I_G + I_SQ + I_QKV + I_SQ + 2 * I_W1 + 2 * I_W2;
        for (int it = gw; it < NITEMS; it += NGW) {
            int r = it;
            if (r < I_WIN) { transpose_item(p.lru_w_in, D, NLRU2, WinT, nullptr, 0, 0, 0, scr, r, lane); continue; } r -= I_WIN;
            if (r < I_G) { const int mi = r / I_G1, g = mi >> 2, blk = mi & 3;
                transpose_item(p.lru_gate_w + (size_t)mi * 65536, 256, 256, GwT, nullptr, 1, blk * 512 + g * 128, 1 << 30, scr, r % I_G1, lane); continue; } r -= I_G;
            if (r < I_SQ) { transpose_item(p.lru_w_out, D, D, WoutT, nullptr, 0, 0, 0, scr, r, lane); continue; } r -= I_SQ;
            if (r < I_QKV) { transpose_item(p.attn_w_qkv, D, NQKV, WqkvT, p.mix_norm + D, 0, 0, 0, scr, r, lane); continue; } r -= I_QKV;
            if (r < I_SQ) { transpose_item(p.attn_w_o, D, D, WoT, nullptr, 0, 0, 0, scr, r, lane); continue; } r -= I_SQ;
            if (r < 2 * I_W1) { const int l = r / I_W1; transpose_item(p.ffn_w_in + (size_t)l * D * NFF2, D, NFF2, W1T + (size_t)l * NFF2 * D, p.ffn_norm + l * D, 1, 0, FF, scr, r % I_W1, lane); continue; } r -= 2 * I_W1;
            { const int l = r / I_W2; transpose_item(p.ffn_w_out + (size_t)l * FF * D, FF, D, W2T + (size_t)l * D * FF, nullptr, 0, 0, 0, scr, r % I_W2, lane); }
        }
        for (int m = 2 * gw; m < M; m += 2 * NGW) rms_row2_to_bf16(p.x + (size_t)m * D, p.mix_norm, XN0 + (size_t)m * D, lane);
        if (gt < D) CN[gt] = -8.0f * 1.4426950408889634f * log1pf(expf(-p.lru_lambda[gt]));
        if (bx == 0) for (int i = tid; i < XCD_BAR_WORDS; i += NTHREADS) ((unsigned*)(ws + WS_CTL))[i] = 0u;
    }
    grid.sync();
    const XcdBarrier bar = xcd_barrier_post((unsigned*)(ws + WS_CTL), MISC + 8);

    for (int rep_ = 0; rep_ < 1 + ((DUP_MASK >> 1) & 1); ++rep_) {
        pg8::Gemm g{XN0, WinT, M, NLRU2, D}; pg8::StaticOrder S; S.init(M, NLRU2, G, bx);
        pg8::EpiLruIn E{GB, RP, p.lru_b_in};
        pg8::gemm_phase<pg8::EpiLruIn, pg8::StaticOrder, true, true>(lds, g, S, E);
#ifdef P1_TWICE
        pg8::gemm_phase<pg8::EpiLruIn, pg8::StaticOrder, true, true>(lds, g, S, E);
#endif
    }
    GSYNC();

#ifndef UNFUSED_LRU
    bf16* RECX = (bf16*)(ws + WS_XN0);
    {
        static_assert(NTHREADS % 128 == 0, "a thread keeps its channel chunk across items");
        const int cc = gt & 127, ch = cc * 8;
        float wk[4][8], bia[8];
#pragma unroll
        for (int k = 0; k < 4; ++k) { const f32x4 a = *(const f32x4*)(p.lru_conv_w + k * D + ch), b = *(const f32x4*)(p.lru_conv_w + k * D + ch + 4);
            wk[k][0] = a.x; wk[k][1] = a.y; wk[k][2] = a.z; wk[k][3] = a.w; wk[k][4] = b.x; wk[k][5] = b.y; wk[k][6] = b.z; wk[k][7] = b.w; }
        { const f32x4 a = *(const f32x4*)(p.lru_conv_b + ch), b = *(const f32x4*)(p.lru_conv_b + ch + 4); bia[0] = a.x; bia[1] = a.y; bia[2] = a.z; bia[3] = a.w; bia[4] = b.x; bia[5] = b.y; bia[6] = b.z; bia[7] = b.w; }
        const int NIT = (M / 8) * 128;
        auto load_win = [&](int it, v4u (&win)[11]) { const int row0 = (it >> 7) * 8, t0 = row0 & (SEQ - 1);
#pragma unroll
            for (int i = 0; i < 11; ++i) { const int t = t0 - 3 + i; win[i] = (t >= 0) ? *(const v4u*)(RP + (size_t)(row0 - 3 + i) * D + ch) : (v4u){0u, 0u, 0u, 0u}; } };
        auto conv_store = [&](int it, const v4u (&win)[11]) { const int row0 = (it >> 7) * 8;
            bf16* dst = RECX + ((size_t)(cc >> 5) * M + row0) * 256 + (cc & 31) * 8;
#pragma unroll
            for (int j = 0; j < 8; ++j) {
                float acc[8];
#pragma unroll
                for (int e = 0; e < 8; ++e) acc[e] = bia[e];
#pragma unroll
                for (int k = 0; k < 4; ++k) { const v4u x = win[j + k];
                    acc[0] = lru::fmac(wk[k][0], bflo(x.x), acc[0]); acc[1] = lru::fmac(wk[k][1], bfhi(x.x), acc[1]); acc[2] = lru::fmac(wk[k][2], bflo(x.y), acc[2]); acc[3] = lru::fmac(wk[k][3], bfhi(x.y), acc[3]);
                    acc[4] = lru::fmac(wk[k][4], bflo(x.z), acc[4]); acc[5] = lru::fmac(wk[k][5], bfhi(x.z), acc[5]); acc[6] = lru::fmac(wk[k][6], bflo(x.w), acc[6]); acc[7] = lru::fmac(wk[k][7], bfhi(x.w), acc[7]); }
                v4u o; o.x = pk2(acc[0], acc[1]); o.y = pk2(acc[2], acc[3]); o.z = pk2(acc[4], acc[5]); o.w = pk2(acc[6], acc[7]);
                *(v4u*)(dst + (size_t)j * 256) = o; } };
        v4u wa[11], wb[11];
        if (gt < NIT) load_win(gt, wa);
        for (int it = gt; it < NIT; it += 2 * NGT) {
            if (it + NGT < NIT) load_win(it + NGT, wb);
            conv_store(it, wa);
            if (it + 2 * NGT < NIT) load_win(it + 2 * NGT, wa);
            if (it + NGT < NIT) conv_store(it + NGT, wb);
        }
    }
    GSYNC();

    lru::lru_phase(vcu, G, RECX, M, RP, GB, Y, GwT, p.lru_conv_w, p.lru_conv_b, p.lru_gate_b, CN, lds);
#ifdef LRU_TWICE
    lru::lru_phase(vcu, G, RP, GB, Y, GwT, p.lru_conv_w, p.lru_conv_b, p.lru_gate_b, CN, lds);
#endif
    GSYNC();
#else
    for (int rep_ = 0; rep_ < 1 + ((DUP_MASK >> 2) & 1); ++rep_) {
        for (int it = gt; it < (M / 8) * 128; it += NGT) {
            const int cc = it & 127, tg = it >> 7; const int row0 = tg * 8, t0 = row0 & (SEQ - 1), ch = cc * 8;
            float wk[4][8], bia[8];
#pragma unroll
            for (int k = 0; k < 4; ++k) { const f32x4 a = *(const f32x4*)(p.lru_conv_w + k * D + ch), b = *(const f32x4*)(p.lru_conv_w + k * D + ch + 4);
                wk[k][0] = a.x; wk[k][1] = a.y; wk[k][2] = a.z; wk[k][3] = a.w; wk[k][4] = b.x; wk[k][5] = b.y; wk[k][6] = b.z; wk[k][7] = b.w; }
            { const f32x4 a = *(const f32x4*)(p.lru_conv_b + ch), b = *(const f32x4*)(p.lru_conv_b + ch + 4); bia[0] = a.x; bia[1] = a.y; bia[2] = a.z; bia[3] = a.w; bia[4] = b.x; bia[5] = b.y; bia[6] = b.z; bia[7] = b.w; }
            v4u win[11];
#pragma unroll
            for (int i = 0; i < 11; ++i) { const int t = t0 - 3 + i; win[i] = (t >= 0) ? *(const v4u*)(RP + (size_t)(row0 - 3 + i) * D + ch) : (v4u){0u, 0u, 0u, 0u}; }
            bf16* dst = REC + ((size_t)(cc >> 5) * M + row0) * 256 + (cc & 31) * 8;
#pragma unroll
            for (int j = 0; j < 8; ++j) {
                float acc[8];
#pragma unroll
                for (int e = 0; e < 8; ++e) acc[e] = bia[e];
#pragma unroll
                for (int k = 0; k < 4; ++k) { const v4u x = win[j + k];
                    acc[0] += wk[k][0] * bflo(x.x); acc[1] += wk[k][1] * bfhi(x.x); acc[2] += wk[k][2] * bflo(x.y); acc[3] += wk[k][3] * bfhi(x.y);
                    acc[4] += wk[k][4] * bflo(x.z); acc[5] += wk[k][5] * bfhi(x.z); acc[6] += wk[k][6] * bflo(x.w); acc[7] += wk[k][7] * bfhi(x.w); }
                v4u o; o.x = pk2(acc[0], acc[1]); o.y = pk2(acc[2], acc[3]); o.z = pk2(acc[4], acc[5]); o.w = pk2(acc[6], acc[7]);
                *(v4u*)(dst + (size_t)j * 256) = o; }
        }
    }
    GSYNC();

    for (int rep_ = 0; rep_ < 1 + ((DUP_MASK >> 3) & 1); ++rep_) {
        pg8::Gemm g{REC, GwT, 4 * M, 512, 256}; pg8::GateOrder S; S.base.init(4 * M, 512, G, bx);
        pg8::EpiGate E{REC, p.lru_gate_b, CN, AB, M};
        pg8::gemm_phase<pg8::EpiGate, pg8::GateOrder, true, true>(lds, g, S, E);
#ifdef GATE_TWICE
        { pg8::EpiGate E2{REC, p.lru_gate_b, CN, (unsigned*)(ws + WS_XN0), M}; pg8::gemm_phase<pg8::EpiGate, pg8::GateOrder, true, true>(lds, g, S, E2); }
#endif
    }
    GSYNC();

    for (int rep_ = 0; rep_ < 1 + ((DUP_MASK >> 4) & 1); ++rep_) {
        for (int it = vcu; it < BATCH * 32; it += G) {
            const int b = it >> 5, c = ((it & 31) << 1) + (tid >> 8), ch = (tid & 255) * 4;
            const size_t base = ((size_t)b * SEQ + (size_t)c * 64) * D + ch;
            f32x4 Ap = {1.f, 1.f, 1.f, 1.f}, Hh = {0.f, 0.f, 0.f, 0.f};
#pragma unroll 8
            for (int t = 0; t < 64; ++t) { const v4u w = *(const v4u*)(AB + base + (size_t)t * D);
                const f32x4 a = {__builtin_amdgcn_exp2f(bflo(w.x)), __builtin_amdgcn_exp2f(bflo(w.y)), __builtin_amdgcn_exp2f(bflo(w.z)), __builtin_amdgcn_exp2f(bflo(w.w))};
                const f32x4 bb = {bfhi(w.x), bfhi(w.y), bfhi(w.z), bfhi(w.w)}; Hh = a * Hh + bb; Ap = Ap * a; }
            const size_t ao = ((size_t)b * 64 + c) * D + ch; *(f32x4*)(AGGA + ao) = Ap; *(f32x4*)(AGGB + ao) = Hh;
        }
    }
    GSYNC();
    for (int rep_ = 0; rep_ < 1 + ((DUP_MASK >> 5) & 1); ++rep_) {
        for (int it = vcu; it < BATCH * 32; it += G) {
            const int b = it >> 5, c = ((it & 31) << 1) + (tid >> 8), ch = (tid & 255) * 4;
            f32x4 Hh = {0.f, 0.f, 0.f, 0.f};
            for (int cc = 0; cc < c; ++cc) { const size_t ao = ((size_t)b * 64 + cc) * D + ch; Hh = *(const f32x4*)(AGGA + ao) * Hh + *(const f32x4*)(AGGB + ao); }
            const size_t base = ((size_t)b * SEQ + (size_t)c * 64) * D + ch;
#pragma unroll 8
            for (int t = 0; t < 64; ++t) { const size_t o = base + (size_t)t * D; const v4u w = *(const v4u*)(AB + o);
                const f32x4 a = {__builtin_amdgcn_exp2f(bflo(w.x)), __builtin_amdgcn_exp2f(bflo(w.y)), __builtin_amdgcn_exp2f(bflo(w.z)), __builtin_amdgcn_exp2f(bflo(w.w))};
                const f32x4 bb = {bfhi(w.x), bfhi(w.y), bfhi(w.z), bfhi(w.w)}; Hh = a * Hh + bb;
                const v2u g = *(const v2u*)(GB + o); v2u y; y.x = pk2(bflo(g.x) * Hh.x, bfhi(g.x) * Hh.y); y.y = pk2(bflo(g.y) * Hh.z, bfhi(g.y) * Hh.w); *(v2u*)(Y + o) = y; }
        }
    }
    GSYNC();

#endif
    for (int rep_ = 0; rep_ < 1 + ((DUP_MASK >> 6) & 1); ++rep_) {
        pg8::Gemm g{Y, WoutT, M, D, D}; pg8::StaticOrder S; S.init(M, D, G, bx);
        pg8::EpiResid<false, false, true> E{p.x, nullptr, HB, SS, p.lru_b_out};
        pg8::gemm_phase<pg8::EpiResid<false, false, true>, pg8::StaticOrder, true, true>(lds, g, S, E);
#ifdef P5_TWICE
        pg8::gemm_phase<pg8::EpiResid<false, false>, pg8::StaticOrder, true, true>(lds, g, S, E);
#endif
    }
    GSYNC();
    for (int rep_ = 0; rep_ < 1 + ((DUP_MASK >> 7) & 1); ++rep_) {
        pg8::Gemm g{HB, W1T, M, NFF2, D}; pg8::StaticOrder S; S.init(M, NFF2, G, bx);
        pg8::EpiSwiglu E{SS, HID, FF};
        pg8::gemm_phase<pg8::EpiSwiglu, pg8::StaticOrder, true, true>(lds, g, S, E);
#ifdef P6_TWICE
        pg8::gemm_phase<pg8::EpiSwiglu, pg8::StaticOrder, true, true>(lds, g, S, E);
#endif
    }
    GSYNC();
    {
        pg8::Gemm g{HID, W2T, M, D, FF}; pg8::StaticOrder S; S.init(M, D, G, bx);
#ifdef P7_TWICE
        { pg8::EpiResid<true, false> E2{HB, nullptr, (bf16*)(ws + WS_XN0), SS + 3 * SS_STRIDE, nullptr}; pg8::gemm_phase<pg8::EpiResid<true, false>, pg8::StaticOrder, true, true>(lds, g, S, E2); }
#endif
        pg8::EpiResid<true, false> E{HB, nullptr, HB, SS + SS_STRIDE, nullptr};
        pg8::gemm_phase<pg8::EpiResid<true, false>, pg8::StaticOrder, true, true>(lds, g, S, E);
    }
    GSYNC();
    for (int rep_ = 0; rep_ < 1 + ((DUP_MASK >> 8) & 1); ++rep_) {
        pg8::Gemm g{HB, WqkvT, M, NQKV, D}; pg8::StaticOrder S; S.init(M, NQKV, G, bx);
        static_assert(WS_V - WS_K == WS_K - WS_Q, "Q|K|V equally spaced");
        pg8::EpiQKV E{SS + SS_STRIDE, Qb, (size_t)(WS_K - WS_Q) / 2, 0.125f * 1.4426950408889634f};
        pg8::gemm_phase<pg8::EpiQKV, pg8::StaticOrder, true, true>(lds, g, S, E);
#ifdef P8_TWICE
        pg8::gemm_phase<pg8::EpiQKV, pg8::StaticOrder, true, true>(lds, g, S, E);
#endif
    }
    GSYNC();
    for (int rep_ = 0; rep_ < 1 + ((DUP_MASK >> 9) & 1); ++rep_) sba::attn_phase(vcu, G, Qb, Kb, Vb, Ob, lds);
    GSYNC();
    for (int rep_ = 0; rep_ < 1 + ((DUP_MASK >> 10) & 1); ++rep_) {
        pg8::Gemm g{Ob, WoT, M, D, D}; pg8::StaticOrder S; S.init(M, D, G, bx);
        pg8::EpiResid<true, false> E{HB, nullptr, HB, SS + 2 * SS_STRIDE, nullptr};
        pg8::gemm_phase<pg8::EpiResid<true, false>, pg8::StaticOrder, true, true>(lds, g, S, E);
    }
    GSYNC();
    for (int rep_ = 0; rep_ < 1 + ((DUP_MASK >> 11) & 1); ++rep_) {
        pg8::Gemm g{HB, W1T + (size_t)NFF2 * D, M, NFF2, D}; pg8::StaticOrder S; S.init(M, NFF2, G, bx);
        pg8::EpiSwiglu E{SS + 2 * SS_STRIDE, HID, FF};
        pg8::gemm_phase<pg8::EpiSwiglu, pg8::StaticOrder, true, true>(lds, g, S, E);
    }
    GSYNC();
    {
        pg8::Gemm g{HID, W2T + (size_t)D * FF, M, D, FF}; pg8::StaticOrder S; S.init(M, D, G, bx);
        pg8::EpiResid<true, false> E{HB, nullptr, HB, SS + 3 * SS_STRIDE, nullptr};
        pg8::gemm_phase<pg8::EpiResid<true, false>, pg8::StaticOrder, true, true>(lds, g, S, E);
    }
    GSYNC();
    for (int m = 4 * gw; m < M; m += 4 * NGW) {
        v4u w[4][2]; float rstd[4];
#pragma unroll
        for (int r = 0; r < 4; ++r) { w[r][0] = *((const v4u*)(HB + (size_t)(m + r) * D) + lane); w[r][1] = *((const v4u*)(HB + (size_t)(m + r) * D) + lane + 64); }
#pragma unroll
        for (int r = 0; r < 4; ++r) { const f32x4* sp = (const f32x4*)(SS + 3 * SS_STRIDE + (size_t)(m + r) * 16); const f32x4 a = sp[0], b = sp[1], c = sp[2], d = sp[3];
            const float s = ((a.x + a.y) + (a.z + a.w)) + ((b.x + b.y) + (b.z + b.w)) + ((c.x + c.y) + (c.z + c.w)) + ((d.x + d.y) + (d.z + d.w)); rstd[r] = 1.0f / sqrtf(s * (1.f / D) + 1e-6f); }
        f32x4 gq[2][2];
#pragma unroll
        for (int j = 0; j < 2; ++j) { gq[j][0] = *((const f32x4*)p.final_norm + 2 * lane + 128 * j); gq[j][1] = *((const f32x4*)p.final_norm + 2 * lane + 128 * j + 1); }
#pragma unroll
        for (int j = 0; j < 2; ++j) { const f32x4 g0 = gq[j][0], g1 = gq[j][1];
#pragma unroll
            for (int r = 0; r < 4; ++r) { const v4u ww = w[r][j]; const float rs = rstd[r]; f32x4* o = (f32x4*)(p.out + (size_t)(m + r) * D) + 2 * lane + 128 * j;
                o[0] = (f32x4){bflo(ww.x) * rs * g0.x, bfhi(ww.x) * rs * g0.y, bflo(ww.y) * rs * g0.z, bfhi(ww.y) * rs * g0.w};
                o[1] = (f32x4){bflo(ww.z) * rs * g1.x, bfhi(ww.z) * rs * g1.y, bflo(ww.w) * rs * g1.z, bfhi(ww.w) * rs * g1.w}; } }
    }
}

extern "C" void kernel_launch(void* const* d_in, const int* in_sizes, int n_in, void* d_out, int out_size, void* d_ws, size_t ws_size, hipStream_t stream) {
    static int grid = 0;
    if (grid == 0) {
        if (n_in != 17 || in_sizes[0] != M * D || out_size != M * D || ws_size < WS_END) { fprintf(stderr, "kernel_launch: unexpected shapes (n_in %d, in0 %d, out %d, ws %zu)\n", n_in, n_in > 0 ? in_sizes[0] : -1, out_size, ws_size); grid = -1; return; }
        int dev = 0, cus = 0, per_cu = 0;
        if (hipGetDevice(&dev) != hipSuccess || hipDeviceGetAttribute(&cus, hipDeviceAttributeMultiprocessorCount, dev) != hipSuccess) { grid = -1; return; }
        if (hipFuncSetAttribute((const void*)hybrid_fwd, hipFuncAttributeMaxDynamicSharedMemorySize, LDS_BYTES) != hipSuccess) { fprintf(stderr, "kernel_launch: hipFuncSetAttribute failed\n"); grid = -1; return; }
        if (hipOccupancyMaxActiveBlocksPerMultiprocessor(&per_cu, (const void*)hybrid_fwd, NTHREADS, LDS_BYTES) != hipSuccess || per_cu < 1) { fprintf(stderr, "kernel_launch: occupancy query says %d\n", per_cu); per_cu = 1; }
        (void)hipGetLastError();
        grid = cus;
    }
    if (grid < 0) return;
    Params p{};
    p.x = (const float*)d_in[0]; p.mix_norm = (const float*)d_in[1]; p.ffn_norm = (const float*)d_in[2]; p.final_norm = (const float*)d_in[3];
    p.lru_w_in = (const float*)d_in[4]; p.lru_b_in = (const float*)d_in[5]; p.lru_conv_w = (const float*)d_in[6]; p.lru_conv_b = (const float*)d_in[7];
    p.lru_gate_w = (const float*)d_in[8]; p.lru_gate_b = (const float*)d_in[9]; p.lru_lambda = (const float*)d_in[10]; p.lru_w_out = (const float*)d_in[11]; p.lru_b_out = (const float*)d_in[12];
    p.attn_w_qkv = (const float*)d_in[13]; p.attn_w_o = (const float*)d_in[14]; p.ffn_w_in = (const float*)d_in[15]; p.ffn_w_out = (const float*)d_in[16];
    p.out = (float*)d_out; p.ws = (unsigned char*)d_ws;
    void* args[] = {&p};
    hipError_t e = hipLaunchCooperativeKernel((const void*)hybrid_fwd, dim3(grid), dim3(NTHREADS), args, LDS_BYTES, stream);
    if (e != hipSuccess) fprintf(stderr, "kernel_launch: cooperative launch failed: %s (grid %d)\n", hipGetErrorString(e), grid);
}
```
